# Optimizing an MI355X kernel written in HIP

```python
import jax, jax.numpy as jnp
from jax import lax
import numpy as np

D_MODEL = 1024
BATCH = 32
SEQ = 256
DEPTH = 1
DEC_BATCH = 8
DEC_SEQ = 4096
PAST_LEN = 512

GRID_W = 64
RWKV_WIDTH = D_MODEL // 2
HEAD_SIZE = 64
RWKV_HEADS = RWKV_WIDTH // HEAD_SIZE
CONV_WIDTH = D_MODEL - RWKV_WIDTH
CONV_GROUPS = 8
DECAY_LORA = 64
AAA_LORA = 64
GATE_LORA = 128
D_FF = 4 * D_MODEL
RWKV_SPLITS = (RWKV_WIDTH, RWKV_WIDTH, RWKV_WIDTH, DECAY_LORA, DECAY_LORA, AAA_LORA, AAA_LORA, GATE_LORA)
RWKV_OFFSETS = [int(o) for o in np.cumsum(RWKV_SPLITS)[:-1]]
RWKV_COLS = int(sum(RWKV_SPLITS))
IN_COLS = RWKV_COLS + 3 * CONV_WIDTH
NORM_EPS = 1e-6
GN_EPS = HEAD_SIZE * 1e-5

kernel_name = "hybrid_rwkv7_shortconv_diffusion_step"


def _rmsnorm(x, g):
    xf = x.astype(jnp.float32)
    y = xf * lax.rsqrt(jnp.mean(xf * xf, axis=-1, keepdims=True) + NORM_EPS)
    return (y * g.astype(jnp.float32)).astype(x.dtype)


def _neighbours(z, rows):
    b, l, ch = z.shape
    zg = z.reshape(b, 1, l, ch) if rows is None else z.reshape(b, rows, l // rows, ch)
    n = zg.shape[2]
    zp = jnp.pad(zg, ((0, 0), (0, 0), (1, 1), (0, 0)))
    prev = zp[:, :, :n].reshape(b, l, ch)
    nxt = zp[:, :, 2:].reshape(b, l, ch)
    return prev, nxt


def _rwkv_direction(k, wl, al, w0, w_w2, a0, w_a2, k_a):
    w = -jax.nn.softplus(-(w0 + jnp.tanh(wl) @ w_w2)) - 0.5
    decay = jnp.exp(-jnp.exp(w))
    a = jax.nn.sigmoid(a0 + al @ w_a2)
    k_dir = k * (1.0 + (a - 1.0) * k_a)
    return decay, a, k_dir


def _wkv7_scan(s0, r, w, k, v, kk, a, reverse):
    def step(s, inp):
        r_t, w_t, k_t, v_t, kk_t, a_t = inp
        sa = jnp.einsum('bhij,bhj->bhi', s, kk_t)
        s = (s * w_t[:, :, None, :]
             - sa[..., None] * (kk_t * a_t)[:, :, None, :]
             + v_t[..., None] * k_t[:, :, None, :])
        y = jnp.einsum('bhij,bhj->bhi', s, r_t)
        return s, y
    xs = tuple(jnp.swapaxes(t, 0, 1) for t in (r, w, k, v, kk, a))
    s, ys = lax.scan(step, s0, xs, reverse=reverse)
    return s, jnp.swapaxes(ys, 0, 1)


def _layer(x, mod, s_f0, s_b0, rows, norm1_g, w_in, mu_shift, w0_f, w_w2_f, w0_b, w_w2_b,
           a0_f, w_a2_f, a0_b, w_a2_b, w_g2, k_k, k_a, r_k, ln_x_w, ln_x_b,
           conv_w, conv_gain, w_out, norm2_g, w_ff1, w_ff2):
    b, l, _ = x.shape
    f32 = jnp.float32
    shift_a, scale_a, gate_a, shift_f, scale_f, gate_f = jnp.split(mod[:, None, :], 6, axis=-1)

    h = _rmsnorm(x, norm1_g) * (1 + scale_a) + shift_a
    z = h @ w_in
    z_rwkv = z[..., :RWKV_COLS].astype(f32)
    z_conv = z[..., RWKV_COLS:]

    prev, nxt = _neighbours(z_rwkv, rows)
    z_rwkv = z_rwkv + mu_shift * (0.5 * (prev + nxt) - z_rwkv)
    r, k, v, wl_f, wl_b, al_f, al_b, gl = jnp.split(z_rwkv, RWKV_OFFSETS, axis=-1)
    heads = lambda t: t.reshape(b, l, RWKV_HEADS, HEAD_SIZE)
    kk = heads(k * k_k)
    kk = kk * lax.rsqrt(jnp.sum(kk * kk, axis=-1, keepdims=True) + 1e-12)
    dec_f, a_f, k_f = _rwkv_direction(k, wl_f, al_f, w0_f, w_w2_f, a0_f, w_a2_f, k_a)
    dec_b, a_b, k_b = _rwkv_direction(k, wl_b, al_b, w0_b, w_w2_b, a0_b, w_a2_b, k_a)
    rh, vh, k_fh, k_bh = heads(r), heads(v), heads(k_f), heads(k_b)
    s_f, y_f = _wkv7_scan(s_f0.astype(f32), rh, heads(dec_f), k_fh, vh, kk, heads(a_f), reverse=False)
    s_b, y_b = _wkv7_scan(s_b0.astype(f32), rh, heads(dec_b), k_bh, vh, kk, heads(a_b), reverse=True)
    y = y_f + y_b
    y_mu = jnp.mean(y, axis=-1, keepdims=True)
    y_var = jnp.mean(jnp.square(y - y_mu), axis=-1, keepdims=True)
    yn = ((y - y_mu) * lax.rsqrt(y_var + GN_EPS)).reshape(b, l, RWKV_WIDTH) * ln_x_w + ln_x_b
    bonus = jnp.sum(rh * (k_fh + k_bh) * r_k, axis=-1, keepdims=True) * vh
    g = jax.nn.sigmoid(gl) @ w_g2
    o_rwkv = (yn + bonus.reshape(b, l, RWKV_WIDTH)) * g

    gate_b, gate_c, hc = jnp.split(z_conv, 3, axis=-1)
    u = gate_c * hc
    up, un = _neighbours(u, rows)
    o_conv = gate_b * (conv_w[0] * up + conv_w[1] * u + conv_w[2] * un)
    o_conv = _rmsnorm(o_conv, conv_gain)

    mix = jnp.concatenate([o_rwkv.astype(x.dtype), o_conv.astype(x.dtype)], axis=-1) @ w_out
    x = (x + gate_a * mix).astype(x.dtype)

    h = _rmsnorm(x, norm2_g) * (1 + scale_f) + shift_f
    f = jnp.square(jax.nn.relu(h @ w_ff1)) @ w_ff2
    x = (x + gate_f * f).astype(x.dtype)
    return x, s_f, s_b


def setup_inputs(seed: int = 0) -> dict:
    key = jax.random.key(seed)
    ks = iter(jax.random.split(key, 40))
    nrm = lambda shape, scale: scale * jax.random.normal(next(ks), shape, jnp.float32)
    L, D = DEPTH, D_MODEL
    st = (DEC_BATCH, L, RWKV_HEADS, HEAD_SIZE, HEAD_SIZE)
    return {
        "x_prompt": nrm((BATCH, SEQ, D), 1.0),
        "x_sample": nrm((DEC_BATCH, DEC_SEQ, D), 1.0),
        "c": nrm((DEC_BATCH, D), 1.0),
        "state_rwkv_fwd": nrm(st, 0.5),
        "state_rwkv_bwd": nrm(st, 0.5),
        "c_ctx": nrm((D,), 1.0),
        "w_mod": nrm((L, D, 6 * D), 0.5 * D ** -0.5),
        "b_mod": nrm((L, 6 * D), 0.02),
        "norm1_g": 1.0 + nrm((L, D), 0.02),
        "w_in": nrm((L, D, IN_COLS), D ** -0.5),
        "mu_shift": jax.random.uniform(next(ks), (L, RWKV_COLS), jnp.float32),
        "w0_f": -1.0 + nrm((L, RWKV_WIDTH), 0.5),
        "w_w2_f": nrm((L, DECAY_LORA, RWKV_WIDTH), 0.1 * DECAY_LORA ** -0.5),
        "w0_b": -1.0 + nrm((L, RWKV_WIDTH), 0.5),
        "w_w2_b": nrm((L, DECAY_LORA, RWKV_WIDTH), 0.1 * DECAY_LORA ** -0.5),
        "a0_f": nrm((L, RWKV_WIDTH), 0.1),
        "w_a2_f": nrm((L, AAA_LORA, RWKV_WIDTH), 0.5 * AAA_LORA ** -0.5),
        "a0_b": nrm((L, RWKV_WIDTH), 0.1),
        "w_a2_b": nrm((L, AAA_LORA, RWKV_WIDTH), 0.5 * AAA_LORA ** -0.5),
        "w_g2": nrm((L, GATE_LORA, RWKV_WIDTH), GATE_LORA ** -0.5),
        "k_k": 0.85 + nrm((L, RWKV_WIDTH), 0.02),
        "k_a": 1.0 + nrm((L, RWKV_WIDTH), 0.02),
        "r_k": nrm((L, RWKV_HEADS, HEAD_SIZE), 0.1),
        "ln_x_w": 1.0 + nrm((L, RWKV_WIDTH), 0.02),
        "ln_x_b": nrm((L, RWKV_WIDTH), 0.02),
        "conv_w": nrm((L, 3, CONV_WIDTH), 3 ** -0.5),
        "conv_gain": 1.0 + nrm((L, CONV_WIDTH), 0.02),
        "w_out": nrm((L, D, D), D ** -0.5),
        "norm2_g": 1.0 + nrm((L, D), 0.02),
        "w_ff1": nrm((L, D, D_FF), D ** -0.5),
        "w_ff2": nrm((L, D_FF, D), D_FF ** -0.5),
        "final_g": 1.0 + nrm((D,), 0.02),
    }


def reference(x_prompt, x_sample, c, state_rwkv_fwd, state_rwkv_bwd, c_ctx, w_mod, b_mod,
              norm1_g, w_in, mu_shift, w0_f, w_w2_f, w0_b, w_w2_b, a0_f, w_a2_f, a0_b, w_a2_b,
              w_g2, k_k, k_a, r_k, ln_x_w, ln_x_b, conv_w, conv_gain, w_out, norm2_g,
              w_ff1, w_ff2, final_g):
    rows = x_sample.shape[1] // GRID_W
    b_ctx = x_prompt.shape[0]
    zero_state = jnp.zeros((b_ctx, RWKV_HEADS, HEAD_SIZE, HEAD_SIZE), jnp.float32)
    x_ctx, x_lat = x_prompt, x_sample
    new_f, new_b = [], []
    for i in range(DEPTH):
        lw = dict(norm1_g=norm1_g[i], w_in=w_in[i], mu_shift=mu_shift[i],
                  w0_f=w0_f[i], w_w2_f=w_w2_f[i], w0_b=w0_b[i], w_w2_b=w_w2_b[i],
                  a0_f=a0_f[i], w_a2_f=w_a2_f[i], a0_b=a0_b[i], w_a2_b=w_a2_b[i],
                  w_g2=w_g2[i], k_k=k_k[i], k_a=k_a[i], r_k=r_k[i],
                  ln_x_w=ln_x_w[i], ln_x_b=ln_x_b[i], conv_w=conv_w[i], conv_gain=conv_gain[i],
                  w_out=w_out[i], norm2_g=norm2_g[i], w_ff1=w_ff1[i], w_ff2=w_ff2[i])
        mod_ctx = jnp.broadcast_to(jax.nn.silu(c_ctx) @ w_mod[i] + b_mod[i], (b_ctx, 6 * D_MODEL))
        x_ctx, s_f, s_b = _layer(x_ctx, mod_ctx, zero_state, zero_state, None, **lw)
        new_f.append(s_f)
        new_b.append(s_b)
        mod_lat = jax.nn.silu(c) @ w_mod[i] + b_mod[i]
        x_lat, _, _ = _layer(x_lat, mod_lat, state_rwkv_fwd[:, i], state_rwkv_bwd[:, i], rows, **lw)
    y_prompt = _rmsnorm(x_ctx, final_g)
    y_sample = _rmsnorm(x_lat, final_g)
    new_state_rwkv_fwd = jnp.stack(new_f, axis=1)
    new_state_rwkv_bwd = jnp.stack(new_b, axis=1)
    return (y_prompt, y_sample, new_state_rwkv_fwd, new_state_rwkv_bwd)
```

```cpp
#include <hip/hip_runtime.h>
#include <hip/hip_cooperative_groups.h>
#include <cstdio>
namespace cg = cooperative_groups;

#ifndef MK_MULTI
#define MK_MULTI 0
#endif
#ifndef PH_MASK
#define PH_MASK 0x7ff
#endif
#ifndef P3_SKIP
#define P3_SKIP 0
#endif
#ifndef DUP_MASK
#define DUP_MASK 0
#endif
#ifndef P3DUP_SKIP
#define P3DUP_SKIP 0
#endif
#ifndef DBG_STOP
#define DBG_STOP -1
#endif

typedef unsigned short bf16_t;
typedef short bf16x8 __attribute__((ext_vector_type(8)));
typedef float f32x4 __attribute__((ext_vector_type(4)));
typedef unsigned u32x4 __attribute__((ext_vector_type(4)));
typedef unsigned u32x2 __attribute__((ext_vector_type(2)));
#define LAS __attribute__((address_space(3)))

constexpr int T_CTX = 8192, T_ALL = 40960, DM = 1024, ZC = 3456, ZPAD = 3584, DFF = 4096;
constexpr size_t MiB = 1u << 20;
constexpr size_t WS_MOD = 0, WS_RN = 1 * MiB, WS_SB = 5 * MiB / 2, WS_LORA = 4 * MiB, WS_WIN = 5 * MiB, WS_WOUT = 12 * MiB, WS_W1 = 14 * MiB, WS_W2 = 22 * MiB;
constexpr size_t WS_H = 32 * MiB, WS_AB = 32 * MiB, WS_EF = 72 * MiB, WS_MIX = 112 * MiB, WS_Z = 192 * MiB, WS_YF = 192 * MiB, WS_YB = 272 * MiB, WS_HID = 192 * MiB, WS_EB = 462 * MiB;
constexpr size_t WS_NEED = 512 * MiB;
constexpr size_t OUT_R = 0, OUT_K = 40 * MiB, OUT_V = 80 * MiB, OUT_AF = 120 * MiB;
constexpr size_t OUT_SF = (size_t)T_ALL * DM, OUT_SB = OUT_SF + 32 * 8 * 64 * 64;
constexpr int LDS_BYTES = 131072 + 16;
constexpr size_t WS_BAR = 15 * MiB / 4;

struct Params { const float* in[32]; float* out; unsigned char* ws; int ph_lo, ph_hi; };

typedef __bf16 bf16x2_t __attribute__((ext_vector_type(2)));
typedef float f32x2 __attribute__((ext_vector_type(2)));
__device__ __forceinline__ unsigned cvt_pk_bf16(float lo, float hi) { f32x2 v = {lo, hi}; bf16x2_t b = __builtin_convertvector(v, bf16x2_t); return __builtin_bit_cast(unsigned, b); }
__device__ __forceinline__ bf16_t f2bf(float x) { return (bf16_t)(cvt_pk_bf16(x, 0.f) & 0xffffu); }
__device__ __forceinline__ float bf_lo(unsigned u) { return __uint_as_float(u << 16); }
__device__ __forceinline__ float bf_hi(unsigned u) { return __uint_as_float(u & 0xffff0000u); }
__device__ __forceinline__ float sigmoidf_(float x) { return __builtin_amdgcn_rcpf(1.0f + __expf(-x)); }
__device__ __forceinline__ float tanhf_(float x) { return 1.0f - 2.0f * __builtin_amdgcn_rcpf(__expf(2.0f * x) + 1.0f); }
template <int CTRL> __device__ __forceinline__ float dpp_(float x) { return __builtin_bit_cast(float, __builtin_amdgcn_mov_dpp(__builtin_bit_cast(int, x), CTRL, 0xf, 0xf, true)); }
__device__ __forceinline__ float rowsum16(float x) { x += dpp_<0xB1>(x); x += dpp_<0x4E>(x); x += dpp_<0x141>(x); x += dpp_<0x128>(x); return x; }
__device__ __forceinline__ float wavesum(float x) { x = rowsum16(x); x += __shfl_xor(x, 16); x += __shfl_xor(x, 32); return x; }
__device__ __forceinline__ const float* xrow(const Params& p, int r) { return r < T_CTX ? p.in[0] + (size_t)r * DM : p.in[1] + (size_t)(r - T_CTX) * DM; }
__device__ __forceinline__ f32x4 ld_bf4(const bf16_t* src) { const u32x2 w = *(const u32x2*)src; return (f32x4){bf_lo(w.x), bf_hi(w.x), bf_lo(w.y), bf_hi(w.y)}; }
__device__ __forceinline__ int mod_index(int r) { return r < T_CTX ? 0 : 1 + ((r - T_CTX) >> 12); }

namespace pg8 {
constexpr int BM = 256, BK = 64, HALF = 128, HTB = HALF * BK * 2, NXCD = 8, WGM = 8;
__device__ __forceinline__ int lds_byte(int r, int c) { const int st = (r >> 4) * 2 + (c >> 5), rr = r & 15, cc = c & 31, ob = rr * 64 + cc * 2; return st * 1024 + (ob ^ (((ob >> 9) & 1) << 5)); }
__device__ __forceinline__ void stage_rc(int b, int& R, int& C) { const int st = b / 1024, sb = b % 1024, swz = sb ^ (((sb >> 9) & 1) << 5); R = (st >> 1) * 16 + swz / 64; C = (st & 1) * 32 + (swz % 64) / 2; }
__device__ __forceinline__ int perm32(int rho) { const int n = rho >> 4, i = rho & 15; return 8 * (i >> 2) + 4 * n + (i & 3); }
struct Unit { int pm, pn; };
struct Gemm { const bf16_t* A; const bf16_t* Bt; int M, N, K; };
struct StaticOrder {
    int nM, nN, nwg, G, c;
    __device__ void init(int M, int N, int G_, int c_) { nM = M / BM; nN = N / BM; nwg = nM * nN; G = G_; c = c_; }
    __device__ bool next(int i, Unit& u) const {
        const long L = (long)i * G + c; if (L >= nwg) return false;
        int wgid = (int)L; { const int q = nwg / NXCD, r = nwg % NXCD, xcd = wgid % NXCD, off = wgid / NXCD; wgid = (xcd < r ? xcd * (q + 1) : r * (q + 1) + (xcd - r) * q) + off; }
        const int nig = WGM * nN, gid = wgid / nig, fm = gid * WGM, gsz = (nM - fm) < WGM ? (nM - fm) : WGM;
        u.pm = fm + ((wgid % nig) % gsz); u.pn = (wgid % nig) / gsz; return true;
    }
};

template <class Epi>
__device__ __forceinline__ void gemm_phase(LAS unsigned char* lds, const Gemm g, const StaticOrder& S, const Epi& E) {
    const int tid = threadIdx.x, wid = __builtin_amdgcn_readfirstlane(tid >> 6), lane = tid & 63, wr = wid >> 2, wc = wid & 3, fr = lane & 15, fq = lane >> 4;
    const int K = g.K, nt = K / BK;
    unsigned voffA[2], voffB[2];
#pragma unroll
    for (int i = 0; i < 2; ++i) { int R, C; stage_rc(tid * 16 + i * 8192, R, C); const int Rb = Epi::PERM ? ((R & ~31) + perm32(R & 31)) : R;
        voffA[i] = (unsigned)(R * K + C) * 2u; voffB[i] = (unsigned)(Rb * K + C) * 2u; }
    const size_t kstep = (size_t)(BK * 2);
    const size_t hstep = (size_t)HALF * K * 2;
    const size_t tstep = 2 * hstep;
    const unsigned ldsw = (unsigned)wid * 1024u;
    const int aoff = lds_byte(wr * 64 + fr, fq * 8), boff = lds_byte(wc * 32 + fr, fq * 8);
#define PG8_SA(b, h) (((b) * 2 + (h)) * HTB)
#define PG8_SB(b, h) ((4 + (b) * 2 + (h)) * HTB)
#define PG8_STAGE(bufoff, gbase, voff) do { _Pragma("unroll") for (int _i = 0; _i < 2; ++_i) \
        __builtin_amdgcn_global_load_lds((const unsigned*)((const char*)(gbase) + (voff)[_i]), (LAS unsigned*)(lds + (bufoff) + ldsw + _i * 8192), 16, 0, 0); } while (0)
#define PG8_LDA(dst, b, h) do { _Pragma("unroll") for (int m = 0; m < 4; ++m) _Pragma("unroll") for (int k = 0; k < 2; ++k) dst[m][k] = *(const LAS bf16x8*)(lds + PG8_SA(b, h) + aoff + m * 2048 + k * 1024); } while (0)
#define PG8_LDB(dst, b, h) do { _Pragma("unroll") for (int n = 0; n < 2; ++n) _Pragma("unroll") for (int k = 0; k < 2; ++k) dst[n][k] = *(const LAS bf16x8*)(lds + PG8_SB(b, h) + boff + n * 2048 + k * 1024); } while (0)
#define PG8_MMA(ai, bj, At, Bt) do { __builtin_amdgcn_s_setprio(1); _Pragma("unroll") for (int m = 0; m < 4; ++m) _Pragma("unroll") for (int n = 0; n < 2; ++n) _Pragma("unroll") for (int k = 0; k < 2; ++k) \
        acc[ai][bj][m][n] = __builtin_amdgcn_mfma_f32_16x16x32_bf16(Bt[n][k], At[m][k], acc[ai][bj][m][n], 0, 0, 0); __builtin_amdgcn_s_setprio(0); } while (0)
#define PG8_WAIT_V(n) asm volatile("s_waitcnt vmcnt(" #n ")" ::: "memory")
#define PG8_WAIT_L(n) asm volatile("s_waitcnt lgkmcnt(" #n ")" ::: "memory")
#define PG8_BAR __builtin_amdgcn_s_barrier()
#define PG8_SCHED __builtin_amdgcn_sched_barrier(0)
    Unit cur, nxt; int ui = 0;
    if (!S.next(0, cur)) return;
    f32x4 acc[2][2][4][2];
#pragma unroll
    for (int a = 0; a < 2; ++a)
#pragma unroll
        for (int b = 0; b < 2; ++b)
#pragma unroll
            for (int m = 0; m < 4; ++m)
#pragma unroll
                for (int n = 0; n < 2; ++n) acc[a][b][m][n] = (f32x4){0.f, 0.f, 0.f, 0.f};
    bf16x8 At[4][2], B0[2][2], B1[2][2];
    const char* cA = (const char*)g.A + (size_t)cur.pm * tstep; const char* cB = (const char*)g.Bt + (size_t)cur.pn * tstep;
    PG8_STAGE(PG8_SB(0, 0), cB, voffB); PG8_STAGE(PG8_SA(0, 0), cA, voffA); PG8_STAGE(PG8_SB(0, 1), cB + hstep, voffB); PG8_STAGE(PG8_SA(0, 1), cA + hstep, voffA);
    if (wr == 1) PG8_BAR;
    PG8_WAIT_V(4); PG8_BAR;
    PG8_STAGE(PG8_SB(1, 0), cB + kstep, voffB); PG8_STAGE(PG8_SA(1, 0), cA + kstep, voffA); PG8_STAGE(PG8_SB(1, 1), cB + hstep + kstep, voffB);
    PG8_WAIT_V(6); PG8_BAR;
    for (;;) {
        const bool has_next = S.next(ui + 1, nxt);
        const char* nA = has_next ? (const char*)g.A + (size_t)nxt.pm * tstep : cA; const char* nB = has_next ? (const char*)g.Bt + (size_t)nxt.pn * tstep : cB;
        for (int t = 0; t < nt; t += 2) {
            const bool last = (t == nt - 2);
            const char* a1 = cA + (size_t)(t + 1) * kstep;
            const char* a2 = last ? nA : cA + (size_t)(t + 2) * kstep; const char* b2 = last ? nB : cB + (size_t)(t + 2) * kstep;
            const char* a3 = a2 + kstep; const char* b3 = b2 + kstep;
            PG8_LDB(B0, 0, 0); PG8_SCHED; PG8_LDA(At, 0, 0); PG8_STAGE(PG8_SA(1, 1), a1 + hstep, voffA);
            PG8_WAIT_L(8); PG8_BAR; PG8_WAIT_L(0); PG8_MMA(0, 0, At, B0); PG8_BAR; PG8_SCHED;
            PG8_LDB(B1, 0, 1); PG8_STAGE(PG8_SB(0, 0), b2, voffB);
            PG8_BAR; PG8_WAIT_L(0); PG8_MMA(0, 1, At, B1); PG8_BAR;
            PG8_LDA(At, 0, 1); PG8_STAGE(PG8_SA(0, 0), a2, voffA);
            PG8_BAR; PG8_WAIT_L(0); PG8_MMA(1, 0, At, B0); PG8_BAR; PG8_SCHED;
            PG8_STAGE(PG8_SB(0, 1), b2 + hstep, voffB);
            PG8_WAIT_V(6); PG8_BAR; PG8_MMA(1, 1, At, B1); PG8_BAR;
            PG8_LDB(B0, 1, 0); PG8_SCHED; PG8_LDA(At, 1, 0); PG8_STAGE(PG8_SA(0, 1), a2 + hstep, voffA);
            PG8_WAIT_L(8); PG8_BAR; PG8_WAIT_L(0); PG8_MMA(0, 0, At, B0); PG8_BAR; PG8_SCHED;
            PG8_LDB(B1, 1, 1); PG8_STAGE(PG8_SB(1, 0), b3, voffB);
            PG8_BAR; PG8_WAIT_L(0); PG8_MMA(0, 1, At, B1); PG8_BAR;
            PG8_LDA(At, 1, 1); PG8_STAGE(PG8_SA(1, 0), a3, voffA);
            PG8_BAR; PG8_WAIT_L(0); PG8_MMA(1, 0, At, B0); PG8_BAR; PG8_SCHED;
            PG8_STAGE(PG8_SB(1, 1), b3 + hstep, voffB);
            PG8_WAIT_V(6); PG8_BAR; PG8_MMA(1, 1, At, B1); PG8_BAR;
        }
        E(acc, cur, wr, wc, fr, fq);
        if (!has_next) break;
#pragma unroll
        for (int a = 0; a < 2; ++a)
#pragma unroll
            for (int b = 0; b < 2; ++b)
#pragma unroll
                for (int m = 0; m < 4; ++m)
#pragma unroll
                    for (int n = 0; n < 2; ++n) acc[a][b][m][n] = (f32x4){0.f, 0.f, 0.f, 0.f};
        cur = nxt; cA = nA; cB = nB; ++ui;
    }
    PG8_WAIT_V(0);
    if (wr == 0) PG8_BAR;
    PG8_BAR;
#undef PG8_SA
#undef PG8_SB
#undef PG8_STAGE
#undef PG8_LDA
#undef PG8_LDB
#undef PG8_MMA
#undef PG8_WAIT_V
#undef PG8_WAIT_L
#undef PG8_BAR
#undef PG8_SCHED
}
}

struct EpiZ {
    static constexpr bool PERM = true;
    bf16_t* O;
    __device__ __forceinline__ void operator()(const f32x4 (&acc)[2][2][4][2], const pg8::Unit& u, int wr, int wc, int fr, int fq) const {
        const int row0 = u.pm * 256 + wr * 64 + fr, col0 = u.pn * 256 + wc * 32 + 8 * fq;
#pragma unroll
        for (int ai = 0; ai < 2; ++ai)
#pragma unroll
            for (int m = 0; m < 4; ++m) { bf16_t* rowp = O + (size_t)(row0 + ai * 128 + m * 16) * ZC + col0;
#pragma unroll
                for (int bj = 0; bj < 2; ++bj) if (u.pn * 256 + bj * 128 < ZC) { const f32x4 v0 = acc[ai][bj][m][0], v1 = acc[ai][bj][m][1];
                    u32x4 w; w.x = cvt_pk_bf16(v0[0], v0[1]); w.y = cvt_pk_bf16(v0[2], v0[3]); w.z = cvt_pk_bf16(v1[0], v1[1]); w.w = cvt_pk_bf16(v1[2], v1[3]);
                    *(u32x4*)(rowp + bj * 128) = w; } }
    }
};
struct EpiHid {
    static constexpr bool PERM = true;
    bf16_t* O;
    __device__ __forceinline__ void operator()(const f32x4 (&acc)[2][2][4][2], const pg8::Unit& u, int wr, int wc, int fr, int fq) const {
        const int row0 = u.pm * 256 + wr * 64 + fr, col0 = u.pn * 256 + wc * 32 + 8 * fq;
#pragma unroll
        for (int ai = 0; ai < 2; ++ai)
#pragma unroll
            for (int m = 0; m < 4; ++m) { bf16_t* rowp = O + (size_t)(row0 + ai * 128 + m * 16) * DFF + col0;
#pragma unroll
                for (int bj = 0; bj < 2; ++bj) { f32x4 v0 = acc[ai][bj][m][0], v1 = acc[ai][bj][m][1];
#pragma unroll
                    for (int j = 0; j < 4; ++j) { const float a = fmaxf(v0[j], 0.f), b = fmaxf(v1[j], 0.f); v0[j] = a * a; v1[j] = b * b; }
                    u32x4 w; w.x = cvt_pk_bf16(v0[0], v0[1]); w.y = cvt_pk_bf16(v0[2], v0[3]); w.z = cvt_pk_bf16(v1[0], v1[1]); w.w = cvt_pk_bf16(v1[2], v1[3]);
                    *(u32x4*)(rowp + bj * 128) = w; } }
    }
};
struct EpiX1 {
    static constexpr bool PERM = true;
    Params p; bf16_t* O;
    __device__ __forceinline__ void operator()(const f32x4 (&acc)[2][2][4][2], const pg8::Unit& u, int wr, int wc, int fr, int fq) const {
        const int row0 = u.pm * 256 + wr * 64 + fr, col0 = u.pn * 256 + wc * 32 + 8 * fq;
        const float* gate = (const float*)(p.ws + WS_MOD) + mod_index(u.pm * 256) * 6144 + 2 * 1024 + col0;
        f32x4 gv[2][2];
#pragma unroll
        for (int bj = 0; bj < 2; ++bj)
#pragma unroll
            for (int n = 0; n < 2; ++n) gv[bj][n] = *(const f32x4*)(gate + bj * 128 + 4 * n);
#pragma unroll
        for (int ai = 0; ai < 2; ++ai) {
            f32x4 bv[4][2][2];
#pragma unroll
            for (int m = 0; m < 4; ++m) { const float* brow = xrow(p, row0 + ai * 128 + m * 16) + col0;
#pragma unroll
                for (int bj = 0; bj < 2; ++bj)
#pragma unroll
                    for (int n = 0; n < 2; ++n) bv[m][bj][n] = *(const f32x4*)(brow + bj * 128 + 4 * n); }
#pragma unroll
            for (int m = 0; m < 4; ++m) { bf16_t* orow = O + (size_t)(row0 + ai * 128 + m * 16) * DM + col0;
#pragma unroll
                for (int bj = 0; bj < 2; ++bj) { const f32x4 v0 = bv[m][bj][0] + gv[bj][0] * acc[ai][bj][m][0], v1 = bv[m][bj][1] + gv[bj][1] * acc[ai][bj][m][1];
                    u32x4 w; w.x = cvt_pk_bf16(v0[0], v0[1]); w.y = cvt_pk_bf16(v0[2], v0[3]); w.z = cvt_pk_bf16(v1[0], v1[1]); w.w = cvt_pk_bf16(v1[2], v1[3]);
                    *(u32x4*)(orow + bj * 128) = w; } }
        }
    }
};
struct EpiX2 {
    static constexpr bool PERM = true;
    Params p; const bf16_t* X1; bf16_t* O;
    __device__ __forceinline__ void operator()(const f32x4 (&acc)[2][2][4][2], const pg8::Unit& u, int wr, int wc, int fr, int fq) const {
        const int row0 = u.pm * 256 + wr * 64 + fr, col0 = u.pn * 256 + wc * 32 + 8 * fq;
        const float* gate = (const float*)(p.ws + WS_MOD) + mod_index(u.pm * 256) * 6144 + 5 * 1024 + col0;
        f32x4 gv[2][2];
#pragma unroll
        for (int bj = 0; bj < 2; ++bj)
#pragma unroll
            for (int n = 0; n < 2; ++n) gv[bj][n] = *(const f32x4*)(gate + bj * 128 + 4 * n);
#pragma unroll
        for (int ai = 0; ai < 2; ++ai) {
            u32x4 bv[4][2];
#pragma unroll
            for (int m = 0; m < 4; ++m) { const bf16_t* brow = X1 + (size_t)(row0 + ai * 128 + m * 16) * DM + col0;
#pragma unroll
                for (int bj = 0; bj < 2; ++bj) bv[m][bj] = *(const u32x4*)(brow + bj * 128); }
#pragma unroll
            for (int m = 0; m < 4; ++m) { bf16_t* orow = O + (size_t)(row0 + ai * 128 + m * 16) * DM + col0;
#pragma unroll
                for (int bj = 0; bj < 2; ++bj) { const u32x4 r = bv[m][bj];
                    const f32x4 v0 = (f32x4){bf_lo(r.x), bf_hi(r.x), bf_lo(r.y), bf_hi(r.y)} + gv[bj][0] * acc[ai][bj][m][0], v1 = (f32x4){bf_lo(r.z), bf_hi(r.z), bf_lo(r.w), bf_hi(r.w)} + gv[bj][1] * acc[ai][bj][m][1];
                    u32x4 w; w.x = cvt_pk_bf16(v0[0], v0[1]); w.y = cvt_pk_bf16(v0[2], v0[3]); w.z = cvt_pk_bf16(v1[0], v1[1]); w.w = cvt_pk_bf16(v1[2], v1[3]);
                    *(u32x4*)(orow + bj * 128) = w; } }
        }
    }
};

__device__ void transpose_tile(const float* __restrict__ src, int N, bf16_t* __restrict__ dst, int K, int k0, int n0, float* tile) {
    const int tid = threadIdx.x;
#pragma unroll
    for (int i = 0; i < 2; ++i) { const int kk = (tid >> 4) + 32 * i, n4 = (tid & 15) * 4; const f32x4 v = *(const f32x4*)(src + (size_t)(k0 + kk) * N + n0 + n4);
        tile[kk * 65 + n4] = v[0]; tile[kk * 65 + n4 + 1] = v[1]; tile[kk * 65 + n4 + 2] = v[2]; tile[kk * 65 + n4 + 3] = v[3]; }
    __syncthreads();
    { const int n = tid >> 3, k8 = (tid & 7) * 8; u32x4 w;
      w.x = cvt_pk_bf16(tile[(k8 + 0) * 65 + n], tile[(k8 + 1) * 65 + n]); w.y = cvt_pk_bf16(tile[(k8 + 2) * 65 + n], tile[(k8 + 3) * 65 + n]);
      w.z = cvt_pk_bf16(tile[(k8 + 4) * 65 + n], tile[(k8 + 5) * 65 + n]); w.w = cvt_pk_bf16(tile[(k8 + 6) * 65 + n], tile[(k8 + 7) * 65 + n]);
      *(u32x4*)(dst + (size_t)(n0 + n) * K + k0 + k8) = w; }
    __syncthreads();
}

__device__ void phase_setup(const Params& p, unsigned char* lds) {
    const int tid = threadIdx.x;
    float* sl = (float*)lds;
    float* red = (float*)(lds + 36864);
    float* modp = (float*)(p.ws + WS_MOD);
    for (int chunk = blockIdx.x; chunk < 256; chunk += gridDim.x) {
        for (int idx = tid; idx < 9216; idx += 512) { const int v = idx >> 10, k = idx & 1023; const float x = v == 0 ? p.in[5][k] : p.in[2][(v - 1) * 1024 + k]; sl[idx] = x / (1.0f + __expf(-x)); }
        __syncthreads();
        const int n0 = chunk * 24;
        if (tid < 510) {
            const int kg = tid / 6, c4 = tid % 6;
            f32x4 acc[9];
#pragma unroll
            for (int v = 0; v < 9; ++v) acc[v] = (f32x4){0.f, 0.f, 0.f, 0.f};
            for (int k = kg; k < 1024; k += 85) { const f32x4 w = *(const f32x4*)(p.in[6] + (size_t)k * 6144 + n0 + c4 * 4);
#pragma unroll
                for (int v = 0; v < 9; ++v) acc[v] += sl[v * 1024 + k] * w; }
#pragma unroll
            for (int v = 0; v < 9; ++v) *(f32x4*)(red + kg * 216 + v * 24 + c4 * 4) = acc[v];
        }
        __syncthreads();
        if (tid < 216) { float s = 0.f; for (int kg = 0; kg < 85; ++kg) s += red[kg * 216 + tid]; const int v = tid / 24, cc = tid % 24; modp[v * 6144 + n0 + cc] = s + p.in[7][n0 + cc]; }
        __syncthreads();
    }
    float* tile = (float*)lds;
    for (int t = blockIdx.x; t < 3168; t += gridDim.x) {
        if (t < 864) { const int kt = t / 54, ntl = t % 54; transpose_tile(p.in[9], ZC, (bf16_t*)(p.ws + WS_WIN), 1024, kt * 64, ntl * 64, tile); }
        else if (t < 1120) { const int u = t - 864; transpose_tile(p.in[27], 1024, (bf16_t*)(p.ws + WS_WOUT), 1024, (u >> 4) * 64, (u & 15) * 64, tile); }
        else if (t < 2144) { const int u = t - 1120; transpose_tile(p.in[29], 4096, (bf16_t*)(p.ws + WS_W1), 1024, (u >> 6) * 64, (u & 63) * 64, tile); }
        else { const int u = t - 2144; transpose_tile(p.in[30], 1024, (bf16_t*)(p.ws + WS_W2), 4096, (u >> 4) * 64, (u & 15) * 64, tile); }
    }
    const int gtid = blockIdx.x * 512 + tid, gsz = gridDim.x * 512;
    for (int i = gtid; i < 128 * 1024 / 8; i += gsz) *(u32x4*)((bf16_t*)(p.ws + WS_WIN) + (size_t)ZC * 1024 + (size_t)i * 8) = (u32x4){0u, 0u, 0u, 0u};
    bf16_t* lw = (bf16_t*)(p.ws + WS_LORA);
    for (int o = gtid; o < 4 * 32768 + 65536; o += gsz) {
        if (o < 4 * 32768) { const int mtx = o >> 15, r = o & 32767, n = r >> 6, k = r & 63; const float* src = p.in[mtx == 0 ? 12 : mtx == 1 ? 14 : mtx == 2 ? 16 : 18];
            lw[o] = (bf16_t)(cvt_pk_bf16(src[k * 512 + n], 0.f) & 0xffffu); }
        else { const int r = o - 4 * 32768, n = r >> 7, k = r & 127; lw[o] = (bf16_t)(cvt_pk_bf16(p.in[19][k * 512 + n], 0.f) & 0xffffu); }
    }
}

template <int MODE>
__device__ void phase_norm(const Params& p) {
    const int lane = threadIdx.x & 63, wid = threadIdx.x >> 6;
    const float* modp = (const float*)(p.ws + WS_MOD);
    const float* gam = MODE == 0 ? p.in[8] : MODE == 1 ? p.in[28] : p.in[31];
    bf16_t* H = (bf16_t*)(p.ws + (MODE == 1 ? WS_MIX : WS_H));
    const bf16_t* X1 = (const bf16_t*)(p.ws + WS_H);
    f32x4 g[4];
#pragma unroll
    for (int i = 0; i < 4; ++i) g[i] = *(const f32x4*)(gam + lane * 4 + 256 * i);
    for (int row0 = (blockIdx.x * 8 + wid) * 2; row0 < T_ALL; row0 += gridDim.x * 16) {
        f32x4 x[2][4], sh[2][4], sc[2][4];
#pragma unroll
        for (int u = 0; u < 2; ++u) { const int row = row0 + u; const float* src = MODE == 0 ? xrow(p, row) : p.out + (size_t)row * DM;
#pragma unroll
            for (int i = 0; i < 4; ++i) { if (MODE == 1) x[u][i] = ld_bf4(X1 + (size_t)row * DM + lane * 4 + 256 * i); else if (MODE == 2) x[u][i] = ld_bf4((const bf16_t*)(p.ws + WS_MIX) + (size_t)row * DM + lane * 4 + 256 * i); else x[u][i] = *(const f32x4*)(src + lane * 4 + 256 * i); }
            if (MODE != 2) { const float* mb = modp + mod_index(row) * 6144 + (MODE == 0 ? 0 : 3) * 1024;
#pragma unroll
                for (int i = 0; i < 4; ++i) { sh[u][i] = *(const f32x4*)(mb + lane * 4 + 256 * i); sc[u][i] = *(const f32x4*)(mb + 1024 + lane * 4 + 256 * i); } } }
#pragma unroll
        for (int u = 0; u < 2; ++u) { const int row = row0 + u; float ss = 0.f;
#pragma unroll
            for (int i = 0; i < 4; ++i) ss += x[u][i][0] * x[u][i][0] + x[u][i][1] * x[u][i][1] + x[u][i][2] * x[u][i][2] + x[u][i][3] * x[u][i][3];
            ss = wavesum(ss);
            const float rs = rsqrtf(ss * (1.0f / 1024.0f) + 1e-6f);
            if (MODE == 2) {
#pragma unroll
                for (int i = 0; i < 4; ++i) *(f32x4*)(p.out + (size_t)row * DM + lane * 4 + 256 * i) = x[u][i] * rs * g[i];
            } else {
#pragma unroll
                for (int i = 0; i < 4; ++i) { const f32x4 y = x[u][i] * rs * g[i] * (1.0f + sc[u][i]) + sh[u][i];
                    u32x2 w; w.x = cvt_pk_bf16(y[0], y[1]); w.y = cvt_pk_bf16(y[2], y[3]);
                    *(u32x2*)(H + (size_t)row * DM + lane * 4 + 256 * i) = w; }
            } }
    }
}

constexpr int XAS = 392;
template <int KL> __device__ __forceinline__ void lora_mma(f32x4 (&acc)[2], const bf16_t* XA, int m, int coff, const bf16_t* WT, int w, int n0, int fr, int fq) {
#pragma unroll
    for (int n = 0; n < 2; ++n) acc[n] = (f32x4){0.f, 0.f, 0.f, 0.f};
#pragma unroll
    for (int kk = 0; kk < KL / 32; ++kk) {
        const bf16x8 xf = *(const bf16x8*)(XA + (m * 16 + fr) * XAS + coff + kk * 32 + fq * 8);
#pragma unroll
        for (int n = 0; n < 2; ++n) { const bf16x8 wf = *(const bf16x8*)(WT + (size_t)(w * 64 + n0 * 16 + 8 * (fr >> 2) + 4 * n + (fr & 3)) * KL + kk * 32 + fq * 8);
            acc[n] = __builtin_amdgcn_mfma_f32_16x16x32_bf16(wf, xf, acc[n], 0, 0, 0); }
    }
}
template <int KL> __device__ __forceinline__ void lora_mma4(f32x4 (&acc)[4], const bf16_t* XA, int m, int coff, const bf16_t* WT, int w, int fr, int fq) {
#pragma unroll
    for (int n = 0; n < 4; ++n) acc[n] = (f32x4){0.f, 0.f, 0.f, 0.f};
#pragma unroll
    for (int kk = 0; kk < KL / 32; ++kk) {
        const bf16x8 xf = *(const bf16x8*)(XA + (m * 16 + fr) * XAS + coff + kk * 32 + fq * 8);
#pragma unroll
        for (int n = 0; n < 4; ++n) { const bf16x8 wf = *(const bf16x8*)(WT + (size_t)(w * 64 + 16 * (fr >> 2) + 4 * n + (fr & 3)) * KL + kk * 32 + fq * 8);
            acc[n] = __builtin_amdgcn_mfma_f32_16x16x32_bf16(wf, xf, acc[n], 0, 0, 0); }
    }
}
__device__ __forceinline__ void lora_loadw(bf16x8 (&wq)[8], const bf16_t* WT, int KS, int koff, int w, int fr, int fq) {
#pragma unroll
    for (int kk = 0; kk < 2; ++kk)
#pragma unroll
        for (int n = 0; n < 4; ++n) wq[kk * 4 + n] = *(const bf16x8*)(WT + (size_t)(w * 64 + 16 * (fr >> 2) + 4 * n + (fr & 3)) * KS + koff + kk * 32 + fq * 8);
}
template <bool ZERO> __device__ __forceinline__ void lora_mma4w(f32x4 (&acc)[4], const bf16_t* XA, int m, int coff, const bf16x8 (&wq)[8], int fr, int fq) {
    if (ZERO) {
#pragma unroll
        for (int n = 0; n < 4; ++n) acc[n] = (f32x4){0.f, 0.f, 0.f, 0.f}; }
#pragma unroll
    for (int kk = 0; kk < 2; ++kk) {
        const bf16x8 xf = *(const bf16x8*)(XA + (m * 16 + fr) * XAS + coff + kk * 32 + fq * 8);
#pragma unroll
        for (int n = 0; n < 4; ++n) acc[n] = __builtin_amdgcn_mfma_f32_16x16x32_bf16(wq[kk * 4 + n], xf, acc[n], 0, 0, 0);
    }
}
__device__ __forceinline__ void st_bf4(bf16_t* dst, const f32x4 v) { u32x2 w; w.x = cvt_pk_bf16(v[0], v[1]); w.y = cvt_pk_bf16(v[2], v[3]); *(u32x2*)dst = w; }

template <int SKIP> __device__ void phase_prep(const Params& p, unsigned char* lds) {
    bf16_t* XA = (bf16_t*)lds;
    const bf16_t* Z = (const bf16_t*)(p.ws + WS_Z);
    const float* mu = p.in[10];
    const bf16_t* lw = (const bf16_t*)(p.ws + WS_LORA);
    bf16_t* MIX = (bf16_t*)(p.ws + WS_MIX);
    bf16_t* Rr = (bf16_t*)((unsigned char*)p.out + OUT_R); bf16_t* Kr = (bf16_t*)((unsigned char*)p.out + OUT_K); bf16_t* Vr = (bf16_t*)((unsigned char*)p.out + OUT_V);
    bf16_t* AF = (bf16_t*)((unsigned char*)p.out + OUT_AF); bf16_t* AB = (bf16_t*)(p.ws + WS_AB); bf16_t* EF = (bf16_t*)(p.ws + WS_EF); bf16_t* EB = (bf16_t*)(p.ws + WS_EB);
    float* RN = (float*)(p.ws + WS_RN); float* SBv = (float*)(p.ws + WS_SB);
    const int tid = threadIdx.x, wid = tid >> 6, lane = tid & 63, fr = lane & 15, fq = lane >> 4;
    float* CT = (float*)(lds + 25600);
    for (int i = tid; i < 5120; i += 512) { const int a = i >> 9, c = i & 511;
        const float* src = a == 0 ? p.in[11] : a == 1 ? p.in[13] : a == 2 ? p.in[15] : a == 3 ? p.in[17] : a == 4 ? mu : a == 5 ? mu + 512 : a == 6 ? mu + 1024 : a == 7 ? p.in[20] : a == 8 ? p.in[21] : p.in[22];
        CT[i] = src[c]; }
    for (int i = tid; i < 384; i += 512) CT[5120 + i] = mu[1536 + i];
    __syncthreads();
    for (int tile = blockIdx.x; tile < T_ALL / 32; tile += gridDim.x) {
        const int t0 = tile * 32, segm = t0 < T_CTX ? 255 : 63;
#pragma unroll
        for (int i = 0; i < 3; ++i) {
            const int item = tid + 512 * i, row = item / 48, c8 = (item % 48) * 8, gt = t0 + row, pos = gt & segm;
            const int hp = pos != 0, hn = pos != segm;
            const u32x4 zc = *(const u32x4*)(Z + (size_t)gt * ZC + 1536 + c8), zp = *(const u32x4*)(Z + (size_t)(gt - hp) * ZC + 1536 + c8), zn = *(const u32x4*)(Z + (size_t)(gt + hn) * ZC + 1536 + c8);
            const f32x4 m0 = *(const f32x4*)(CT + 5120 + c8), m1 = *(const f32x4*)(CT + 5120 + c8 + 4);
            float s[8];
            const bool ident_ = c8 >= 128 && c8 < 256; const float ab_ = c8 < 128 ? 2.0f : 1.0f, cc_ = c8 < 128 ? -1.0f : 0.0f;
#pragma unroll
            for (int e = 0; e < 8; ++e) { const unsigned uc = zc[e >> 1], up = zp[e >> 1], un = zn[e >> 1];
                const float z = (e & 1) ? bf_hi(uc) : bf_lo(uc); float pv = (e & 1) ? bf_hi(up) : bf_lo(up); float nv = (e & 1) ? bf_hi(un) : bf_lo(un);
                pv = hp ? pv : 0.f; nv = hn ? nv : 0.f; const float m = e < 4 ? m0[e & 3] : m1[e & 3];
                const float v = z + m * (0.5f * (pv + nv) - z);
                const float sg_ = sigmoidf_(v * ab_);
                s[e] = ident_ ? v : sg_ * ab_ + cc_; }
            u32x4 w; w.x = cvt_pk_bf16(s[0], s[1]); w.y = cvt_pk_bf16(s[2], s[3]); w.z = cvt_pk_bf16(s[4], s[5]); w.w = cvt_pk_bf16(s[6], s[7]);
            *(u32x4*)(XA + row * XAS + c8) = w;
        }
        __syncthreads();
#pragma unroll 1
        for (int m = 0; m < ((SKIP & 1) ? 0 : 2); ++m) {
            const int w = wid, gt = t0 + m * 16 + fr, pos = gt & segm, hp = pos != 0, hn = pos != segm;
            const bf16_t* zc = Z + (size_t)gt * ZC; const bf16_t* zp = Z + (size_t)(gt - hp) * ZC; const bf16_t* zn = Z + (size_t)(gt + hn) * ZC;
            const int cb16 = w * 64 + 16 * fq;
            u32x4 zr[2][3], zk[2][3], zv[2][3];
            f32x4 acc[4], aaf[4], aab[4];
#define P3_ST16(DST, V0, V1, V2, V3) do { u32x4 w0_, w1_; w0_.x = cvt_pk_bf16((V0)[0], (V0)[1]); w0_.y = cvt_pk_bf16((V0)[2], (V0)[3]); w0_.z = cvt_pk_bf16((V1)[0], (V1)[1]); w0_.w = cvt_pk_bf16((V1)[2], (V1)[3]); \
                w1_.x = cvt_pk_bf16((V2)[0], (V2)[1]); w1_.y = cvt_pk_bf16((V2)[2], (V2)[3]); w1_.z = cvt_pk_bf16((V3)[0], (V3)[1]); w1_.w = cvt_pk_bf16((V3)[2], (V3)[3]); \
                *(u32x4*)(DST) = w0_; *(u32x4*)((DST) + 8) = w1_; } while (0)
            {
                bf16x8 w1[8], w2[8];
                lora_loadw(w1, lw, 64, 0, w, fr, fq);
                __builtin_amdgcn_sched_barrier(0);
                lora_loadw(w2, lw + 32768, 64, 0, w, fr, fq);
                lora_mma4w<true>(acc, XA, m, 0, w1, fr, fq);
                __builtin_amdgcn_sched_barrier(0);
                { f32x4 e[4];
#pragma unroll
                  for (int n = 0; n < 4; ++n) { const f32x4 b = *(const f32x4*)(CT + cb16 + 4 * n);
#pragma unroll
                      for (int j = 0; j < 4; ++j) e[n][j] = sigmoidf_(b[j] + acc[n][j]) * 0.60653066f; }
                  P3_ST16(EF + (size_t)gt * 512 + cb16, e[0], e[1], e[2], e[3]); }
                __builtin_amdgcn_sched_barrier(0);
                lora_loadw(w1, lw + 4 * 32768, 128, 0, w, fr, fq);
                lora_mma4w<true>(acc, XA, m, 64, w2, fr, fq);
                __builtin_amdgcn_sched_barrier(0);
                { f32x4 e[4];
#pragma unroll
                  for (int n = 0; n < 4; ++n) { const f32x4 b = *(const f32x4*)(CT + 512 + cb16 + 4 * n);
#pragma unroll
                      for (int j = 0; j < 4; ++j) e[n][j] = sigmoidf_(b[j] + acc[n][j]) * 0.60653066f; }
                  P3_ST16(EB + (size_t)gt * 512 + cb16, e[0], e[1], e[2], e[3]); }
                __builtin_amdgcn_sched_barrier(0);
#pragma unroll
            for (int hh = 0; hh < 2; ++hh) { const int c_ = cb16 + 8 * hh;
                zr[hh][0] = *(const u32x4*)(zc + c_); zk[hh][0] = *(const u32x4*)(zc + 512 + c_); zv[hh][0] = *(const u32x4*)(zc + 1024 + c_); }
                lora_loadw(w2, lw + 4 * 32768, 128, 64, w, fr, fq);
                lora_mma4w<true>(acc, XA, m, 256, w1, fr, fq);
                __builtin_amdgcn_sched_barrier(0);
                lora_loadw(w1, lw + 2 * 32768, 64, 0, w, fr, fq);
                lora_mma4w<false>(acc, XA, m, 256 + 64, w2, fr, fq);
                __builtin_amdgcn_sched_barrier(0);
                P3_ST16(MIX + (size_t)gt * DM + cb16, acc[0], acc[1], acc[2], acc[3]);
                __builtin_amdgcn_sched_barrier(0);
#pragma unroll
            for (int hh = 0; hh < 2; ++hh) { const int c_ = cb16 + 8 * hh;
                zr[hh][1] = *(const u32x4*)(zp + c_); zr[hh][2] = *(const u32x4*)(zn + c_); zk[hh][1] = *(const u32x4*)(zp + 512 + c_); zk[hh][2] = *(const u32x4*)(zn + 512 + c_);
                zv[hh][1] = *(const u32x4*)(zp + 1024 + c_); zv[hh][2] = *(const u32x4*)(zn + 1024 + c_); }
                lora_loadw(w2, lw + 3 * 32768, 64, 0, w, fr, fq);
                lora_mma4w<true>(aaf, XA, m, 128, w1, fr, fq);
                __builtin_amdgcn_sched_barrier(0);
                lora_mma4w<true>(aab, XA, m, 192, w2, fr, fq);
            }
            const float fp = hp ? 0.5f : 0.f, fn = hn ? 0.5f : 0.f;
            float ss = 0.f, sbp = 0.f;
#define P3_ST8(DST, V0, V1) do { u32x4 w0_; w0_.x = cvt_pk_bf16((V0)[0], (V0)[1]); w0_.y = cvt_pk_bf16((V0)[2], (V0)[3]); w0_.z = cvt_pk_bf16((V1)[0], (V1)[1]); w0_.w = cvt_pk_bf16((V1)[2], (V1)[3]); *(u32x4*)(DST) = w0_; } while (0)
#pragma unroll
            for (int hh = 0; hh < 2; ++hh) {
                f32x4 rr[2], kk2[2], vv2[2], af2[2], ab2[2];
#pragma unroll
                for (int q2 = 0; q2 < 2; ++q2) {
                    const int n = 2 * hh + q2, cb = cb16 + 4 * n;
                    const f32x4 a0f = *(const f32x4*)(CT + 1024 + cb), a0b = *(const f32x4*)(CT + 1536 + cb);
                    f32x4 af, ab;
#pragma unroll
                    for (int j = 0; j < 4; ++j) { af[j] = sigmoidf_(a0f[j] + aaf[n][j]); ab[j] = sigmoidf_(a0b[j] + aab[n][j]); }
#define UNP(U) ((f32x4){bf_lo((U)[2 * q2]), bf_hi((U)[2 * q2]), bf_lo((U)[2 * q2 + 1]), bf_hi((U)[2 * q2 + 1])})
                    f32x4 r = UNP(zr[hh][0]), k = UNP(zk[hh][0]), v = UNP(zv[hh][0]);
                    { const f32x4 mr = *(const f32x4*)(CT + 2048 + cb), mk = *(const f32x4*)(CT + 2560 + cb), mv = *(const f32x4*)(CT + 3072 + cb);
                      r += mr * (fp * UNP(zr[hh][1]) + fn * UNP(zr[hh][2]) - r);
                      k += mk * (fp * UNP(zk[hh][1]) + fn * UNP(zk[hh][2]) - k);
                      v += mv * (fp * UNP(zv[hh][1]) + fn * UNP(zv[hh][2]) - v); }
#undef UNP
                    const f32x4 kkc = *(const f32x4*)(CT + 3584 + cb), kac = *(const f32x4*)(CT + 4096 + cb), rkc = *(const f32x4*)(CT + 4608 + cb);
#pragma unroll
                    for (int j = 0; j < 4; ++j) { const float t = k[j] * kkc[j]; ss += t * t;
                        const float ksum = k[j] * (2.0f + (af[j] + ab[j] - 2.0f) * kac[j]); sbp += r[j] * ksum * rkc[j]; }
                    rr[q2] = r; kk2[q2] = k; vv2[q2] = v; af2[q2] = af; ab2[q2] = ab;
                }
                const int c_ = cb16 + 8 * hh;
                P3_ST8(AF + (size_t)gt * 512 + c_, af2[0], af2[1]); P3_ST8(AB + (size_t)gt * 512 + c_, ab2[0], ab2[1]);
                P3_ST8(Rr + (size_t)gt * 512 + c_, rr[0], rr[1]); P3_ST8(Kr + (size_t)gt * 512 + c_, kk2[0], kk2[1]); P3_ST8(Vr + (size_t)gt * 512 + c_, vv2[0], vv2[1]);
            }
#undef P3_ST8
#undef P3_ST16
            ss += __shfl_xor(ss, 16); ss += __shfl_xor(ss, 32); sbp += __shfl_xor(sbp, 16); sbp += __shfl_xor(sbp, 32);
            if (fq == 0) { RN[gt * 8 + w] = rsqrtf(ss + 1e-12f); SBv[gt * 8 + w] = sbp; }
        }
#pragma unroll 1
        for (int q2 = 0; q2 < ((SKIP & 2) ? 0 : 2); ++q2) {
            const int c8 = lane * 8;
            u32x4 gb[2], gcc[2], hcc[2], gcp[2], hcp[2], gcn[2], hcn[2]; int hpq[2], hnq[2];
#pragma unroll
            for (int u2 = 0; u2 < 2; ++u2) {
                const int gt = t0 + wid * 4 + q2 * 2 + u2, pos = gt & segm; hpq[u2] = pos != 0; hnq[u2] = pos != segm;
                const bf16_t* zc = Z + (size_t)gt * ZC + 1920 + c8; const bf16_t* zp = Z + (size_t)(gt - hpq[u2]) * ZC + 1920 + c8; const bf16_t* zn = Z + (size_t)(gt + hnq[u2]) * ZC + 1920 + c8;
                gb[u2] = *(const u32x4*)zc; gcc[u2] = *(const u32x4*)(zc + 512); hcc[u2] = *(const u32x4*)(zc + 1024); gcp[u2] = *(const u32x4*)(zp + 512); hcp[u2] = *(const u32x4*)(zp + 1024);
                gcn[u2] = *(const u32x4*)(zn + 512); hcn[u2] = *(const u32x4*)(zn + 1024);
            }
            const float* cw = p.in[25];
            const f32x4 cwa0 = *(const f32x4*)(cw + c8), cwa1 = *(const f32x4*)(cw + c8 + 4), cwb0 = *(const f32x4*)(cw + 512 + c8), cwb1 = *(const f32x4*)(cw + 512 + c8 + 4);
            const f32x4 cwc0 = *(const f32x4*)(cw + 1024 + c8), cwc1 = *(const f32x4*)(cw + 1024 + c8 + 4), cg0 = *(const f32x4*)(p.in[26] + c8), cg1 = *(const f32x4*)(p.in[26] + c8 + 4);
#pragma unroll
            for (int u2 = 0; u2 < 2; ++u2) {
                const int gt = t0 + wid * 4 + q2 * 2 + u2;
                float o[8], ss = 0.f;
#pragma unroll
                for (int e = 0; e < 8; ++e) {
                    const int h2 = e >> 1;
#define BFSEL(U) ((e & 1) ? bf_hi(U[u2][h2]) : bf_lo(U[u2][h2]))
                    const float u = BFSEL(gcc) * BFSEL(hcc), up = hpq[u2] ? BFSEL(gcp) * BFSEL(hcp) : 0.f, un = hnq[u2] ? BFSEL(gcn) * BFSEL(hcn) : 0.f;
                    const float w0 = e < 4 ? cwa0[e & 3] : cwa1[e & 3], w1 = e < 4 ? cwb0[e & 3] : cwb1[e & 3], w2 = e < 4 ? cwc0[e & 3] : cwc1[e & 3];
                    o[e] = BFSEL(gb) * (w0 * up + w1 * u + w2 * un); ss += o[e] * o[e];
#undef BFSEL
                }
                ss = wavesum(ss);
                const float rs = rsqrtf(ss * (1.0f / 512.0f) + 1e-6f);
                u32x4 wv; wv.x = cvt_pk_bf16(o[0] * rs * cg0[0], o[1] * rs * cg0[1]); wv.y = cvt_pk_bf16(o[2] * rs * cg0[2], o[3] * rs * cg0[3]);
                wv.z = cvt_pk_bf16(o[4] * rs * cg1[0], o[5] * rs * cg1[1]); wv.w = cvt_pk_bf16(o[6] * rs * cg1[2], o[7] * rs * cg1[3]);
                *(u32x4*)(MIX + (size_t)gt * DM + 512 + c8) = wv;
            }
        }
        __syncthreads();
    }
}

struct ScanDesc { int base, L, h, hf, dir, b; };
__device__ __forceinline__ ScanDesc scan_decode(bool lat, int uu) {
    ScanDesc d; const int s = uu >> 1; d.hf = uu & 1; d.b = s >> 4; d.h = (s >> 1) & 7; d.dir = s & 1;
    d.L = lat ? 4096 : 256; d.base = lat ? T_CTX + d.b * 4096 : d.b * 256; return d;
}
__device__ __forceinline__ float rowsum8(float x) { x += dpp_<0xB1>(x); x += dpp_<0x4E>(x); x += dpp_<0x141>(x); return x; }
__device__ void phase_scan(const Params& p, unsigned char* lds) {
    constexpr int TC = 16, BUF = 5 * TC * 64 + TC * 32;
    const int tid = threadIdx.x, hb = __builtin_amdgcn_readfirstlane(tid >> 8), lt = tid & 255;
    float* bufs0 = (float*)lds;
    float* bufs = bufs0 + hb * (2 * BUF);
    float* EB = bufs0 + 4 * BUF + 2 * TC * 256;
    float* YP = bufs0 + 4 * BUF;
    const bf16_t* Rr = (const bf16_t*)((unsigned char*)p.out + OUT_R); const bf16_t* Kr = (const bf16_t*)((unsigned char*)p.out + OUT_K); const bf16_t* Vr = (const bf16_t*)((unsigned char*)p.out + OUT_V);
    const float* RN = (const float*)(p.ws + WS_RN);
    const bool lat = hb == 0;
    const int rl = lt >> 3, jo = lt & 7, j8 = jo * 8;
    const int sst = lt >> 4, sj4 = (lt & 15) * 4;
    const int vst = (lt & 127) >> 3, vi4 = (lt & 7) * 4;
    const int ncu_sh = lat ? 8 : 4;
    const int G = gridDim.x, bid = blockIdx.x;
    const int n0 = bid < 256 ? (256 - bid + G - 1) / G : 0, n1 = bid < 1024 ? (1024 - bid + G - 1) / G : 0;
    const int myslots = lat ? (n0 << 8) : (n1 << 4), maxslots = (n0 << 8) > (n1 << 4) ? (n0 << 8) : (n1 << 4);
    const int X = n1 << 4;
    const bool handoff = (n0 == 1) && (n1 == 4);
    const int endA = handoff ? X : maxslots;
    constexpr int RD = 4;
    const int lastslot = myslots > 0 ? myslots - 1 : 0;
    u32x2 pr[RD], pk[RD], pa[RD], pe[RD], pv[RD]; float prn[RD]; f32x4 nkkc[RD], nkac[RD];
#define SC_TOK(d, step) ((d).dir ? (d).base + (d).L - 1 - (step) : (d).base + (step))
#define SC_LOADX(q, slot, LATF, NSH) do { const ScanDesc d_ = scan_decode(LATF, bid + ((slot) >> (NSH)) * G); const int c_ = (slot) & ((1 << (NSH)) - 1); \
        const int t_ = SC_TOK(d_, c_ * TC + sst); const size_t o_ = (size_t)t_ * 512 + d_.h * 64 + sj4; \
        const bf16_t* Ar_ = d_.dir ? (const bf16_t*)(p.ws + WS_AB) : (const bf16_t*)((unsigned char*)p.out + OUT_AF); \
        const bf16_t* Er_ = d_.dir ? (const bf16_t*)(p.ws + WS_EB) : (const bf16_t*)(p.ws + WS_EF); \
        pr[q] = *(const u32x2*)(Rr + o_); pk[q] = *(const u32x2*)(Kr + o_); pa[q] = *(const u32x2*)(Ar_ + o_); pe[q] = *(const u32x2*)(Er_ + o_); prn[q] = RN[t_ * 8 + d_.h]; \
        nkkc[q] = *(const f32x4*)(p.in[20] + d_.h * 64 + sj4); nkac[q] = *(const f32x4*)(p.in[21] + d_.h * 64 + sj4); \
        { const int t2_ = SC_TOK(d_, c_ * TC + vst); pv[q] = *(const u32x2*)(Vr + (size_t)t2_ * 512 + d_.h * 64 + d_.hf * 32 + vi4); } } while (0)
#define SC_CONVX(q, bi, BUFS) do { float* B_ = (BUFS) + (bi) * BUF; \
        const f32x4 r_ = (f32x4){bf_lo(pr[q].x), bf_hi(pr[q].x), bf_lo(pr[q].y), bf_hi(pr[q].y)}, k_ = (f32x4){bf_lo(pk[q].x), bf_hi(pk[q].x), bf_lo(pk[q].y), bf_hi(pk[q].y)}; \
        const f32x4 a_ = (f32x4){bf_lo(pa[q].x), bf_hi(pa[q].x), bf_lo(pa[q].y), bf_hi(pa[q].y)}, e_ = (f32x4){bf_lo(pe[q].x), bf_hi(pe[q].x), bf_lo(pe[q].y), bf_hi(pe[q].y)}; \
        f32x4 w_; w_[0] = __expf(-e_[0]); w_[1] = __expf(-e_[1]); w_[2] = __expf(-e_[2]); w_[3] = __expf(-e_[3]); \
        const f32x4 kk_ = k_ * nkkc[q] * prn[q], kd_ = k_ * (1.0f + (a_ - 1.0f) * nkac[q]), ka_ = kk_ * a_; \
        *(f32x4*)(B_ + 0 * TC * 64 + sst * 64 + sj4) = w_; *(f32x4*)(B_ + 1 * TC * 64 + sst * 64 + sj4) = kd_; *(f32x4*)(B_ + 2 * TC * 64 + sst * 64 + sj4) = ka_; \
        *(f32x4*)(B_ + 3 * TC * 64 + sst * 64 + sj4) = kk_; *(f32x4*)(B_ + 4 * TC * 64 + sst * 64 + sj4) = r_; \
        if (lt < 128) *(f32x4*)(B_ + 5 * TC * 64 + vst * 32 + vi4) = (f32x4){bf_lo(pv[q].x), bf_hi(pv[q].x), bf_lo(pv[q].y), bf_hi(pv[q].y)}; } while (0)
#define SC_LOAD(q, slot) SC_LOADX(q, slot, lat, ncu_sh)
#define SC_CONV(q, bi) SC_CONVX(q, bi, bufs)
#define SC_RD(st, w0_, w1_, k0_, k1_, a0_, a1_, q0_, q1_, r0_, r1_, v_) do { const float* b_ = B + (st) * 64; \
            w0_ = *(const f32x4*)(b_); w1_ = *(const f32x4*)(b_ + 4); k0_ = *(const f32x4*)(b_ + TC * 64); k1_ = *(const f32x4*)(b_ + TC * 64 + 4); \
            a0_ = *(const f32x4*)(b_ + 2 * TC * 64); a1_ = *(const f32x4*)(b_ + 2 * TC * 64 + 4); q0_ = *(const f32x4*)(b_ + 3 * TC * 64); q1_ = *(const f32x4*)(b_ + 3 * TC * 64 + 4); \
            r0_ = *(const f32x4*)(b_ + 4 * TC * 64); r1_ = *(const f32x4*)(b_ + 4 * TC * 64 + 4); v_ = Bv[(st) * 32]; } while (0)
#define SC_COMPUTE(s, LATF, NSH, BUFS, YMODE) do { \
            const int k = (s) >> (NSH), c = (s) & ((1 << (NSH)) - 1); \
            const ScanDesc d = scan_decode(LATF, bid + k * G); \
            const int i = d.hf * 32 + rl; \
            if (c == 0) { \
                if (LATF) { const float* sp = p.in[d.dir ? 4 : 3] + ((size_t)(d.b * 8 + d.h) * 64 + i) * 64 + j8; const f32x4 a = *(const f32x4*)sp, b2 = *(const f32x4*)(sp + 4); \
                    S0 = (f32x2){a[0], a[1]}; S1 = (f32x2){a[2], a[3]}; S2 = (f32x2){b2[0], b2[1]}; S3 = (f32x2){b2[2], b2[3]}; } \
                else { S0 = (f32x2){0.f, 0.f}; S1 = S0; S2 = S0; S3 = S0; } \
            } \
            const float* B = (BUFS) + ((s) & 1) * BUF + j8; \
            const float* Bv = (BUFS) + ((s) & 1) * BUF + 5 * TC * 64 + rl; \
            float yk0 = 0.f, yk1 = 0.f; \
            f32x4 cw0, cw1, ck0, ck1, ca0, ca1, cq0, cq1, cr0, cr1; float cv; \
            SC_RD(0, cw0, cw1, ck0, ck1, ca0, ca1, cq0, cq1, cr0, cr1, cv); \
            _Pragma("unroll") \
            for (int st = 0; st < TC; ++st) { \
                f32x4 nw0, nw1, nk0, nk1, na0, na1, nq0, nq1, nr0, nr1; float nv; \
                if (st + 1 < TC) SC_RD(st + 1, nw0, nw1, nk0, nk1, na0, na1, nq0, nq1, nr0, nr1, nv); \
                f32x2 pq = S0 * (f32x2){cq0[0], cq0[1]}; pq += S1 * (f32x2){cq0[2], cq0[3]}; pq += S2 * (f32x2){cq1[0], cq1[1]}; pq += S3 * (f32x2){cq1[2], cq1[3]}; \
                const f32x2 vv = {cv, cv}; \
                f32x2 t0 = S0 * (f32x2){cw0[0], cw0[1]} + vv * (f32x2){ck0[0], ck0[1]}, t1 = S1 * (f32x2){cw0[2], cw0[3]} + vv * (f32x2){ck0[2], ck0[3]}; \
                f32x2 t2 = S2 * (f32x2){cw1[0], cw1[1]} + vv * (f32x2){ck1[0], ck1[1]}, t3 = S3 * (f32x2){cw1[2], cw1[3]} + vv * (f32x2){ck1[2], ck1[3]}; \
                const float sa = rowsum8(pq[0] + pq[1]); \
                const f32x2 nsa = {-sa, -sa}; \
                S0 = t0 + nsa * (f32x2){ca0[0], ca0[1]}; S1 = t1 + nsa * (f32x2){ca0[2], ca0[3]}; S2 = t2 + nsa * (f32x2){ca1[0], ca1[1]}; S3 = t3 + nsa * (f32x2){ca1[2], ca1[3]}; \
                f32x2 py = S0 * (f32x2){cr0[0], cr0[1]}; py += S1 * (f32x2){cr0[2], cr0[3]}; py += S2 * (f32x2){cr1[0], cr1[1]}; py += S3 * (f32x2){cr1[2], cr1[3]}; \
                if (YMODE) YP[((s) & 1) * (TC * 256) + st * 256 + lt] = py[0] + py[1];        \
                else { const float y = rowsum8(py[0] + py[1]); \
                       if (st < 8) yk0 = (jo == (st & 7)) ? y : yk0; else yk1 = (jo == (st & 7)) ? y : yk1; } \
                if (st + 1 < TC) { cw0 = nw0; cw1 = nw1; ck0 = nk0; ck1 = nk1; ca0 = na0; ca1 = na1; cq0 = nq0; cq1 = nq1; cr0 = nr0; cr1 = nr1; cv = nv; } \
            } \
            if (!(YMODE)) { bf16_t* Yg = (bf16_t*)(p.ws + (d.dir ? WS_YB : WS_YF)); const int ta = SC_TOK(d, c * TC + jo), tb = SC_TOK(d, c * TC + 8 + jo); \
              Yg[(size_t)ta * 512 + d.h * 64 + i] = f2bf(yk0); Yg[(size_t)tb * 512 + d.h * 64 + i] = f2bf(yk1); } \
            if (!(LATF) && c == (1 << (NSH)) - 1) { float* sp = p.out + (d.dir ? OUT_SB : OUT_SF) + ((size_t)(d.b * 8 + d.h) * 64 + i) * 64 + j8; \
                *(f32x4*)sp = (f32x4){S0[0], S0[1], S1[0], S1[1]}; *(f32x4*)(sp + 4) = (f32x4){S2[0], S2[1], S3[0], S3[1]}; } \
        } while (0)
#define SC_COMPUTE_F(s) do { \
            const float* B = bufs0 + ((s) & 1) * BUF + j8; \
            const float* Bv = bufs0 + ((s) & 1) * BUF + 5 * TC * 64 + rl; \
            f32x4 ck0, ck1, ca0, ca1, cq0, cq1, cr0, cr1; float cv; \
            { const float* b_ = B; ck0 = *(const f32x4*)(b_ + TC * 64); ck1 = *(const f32x4*)(b_ + TC * 64 + 4); ca0 = *(const f32x4*)(b_ + 2 * TC * 64); ca1 = *(const f32x4*)(b_ + 2 * TC * 64 + 4); \
              cq0 = *(const f32x4*)(b_ + 3 * TC * 64); cq1 = *(const f32x4*)(b_ + 3 * TC * 64 + 4); cr0 = *(const f32x4*)(b_ + 4 * TC * 64); cr1 = *(const f32x4*)(b_ + 4 * TC * 64 + 4); cv = Bv[0]; } \
            _Pragma("unroll") \
            for (int st = 0; st < TC; ++st) { \
                f32x4 nk0, nk1, na0, na1, nq0, nq1, nr0, nr1; float nv; \
                if (st + 1 < TC) { const float* b_ = B + (st + 1) * 64; nk0 = *(const f32x4*)(b_ + TC * 64); nk1 = *(const f32x4*)(b_ + TC * 64 + 4); na0 = *(const f32x4*)(b_ + 2 * TC * 64); na1 = *(const f32x4*)(b_ + 2 * TC * 64 + 4); \
                    nq0 = *(const f32x4*)(b_ + 3 * TC * 64); nq1 = *(const f32x4*)(b_ + 3 * TC * 64 + 4); nr0 = *(const f32x4*)(b_ + 4 * TC * 64); nr1 = *(const f32x4*)(b_ + 4 * TC * 64 + 4); nv = Bv[(st + 1) * 32]; } \
                f32x2 pq = S0 * (f32x2){cq0[0], cq0[1]}; pq += S1 * (f32x2){cq0[2], cq0[3]}; pq += S2 * (f32x2){cq1[0], cq1[1]}; pq += S3 * (f32x2){cq1[2], cq1[3]}; \
                const f32x2 vv = {cv, cv}; \
                const f32x2 t0 = S0 + vv * (f32x2){ck0[0], ck0[1]}, t1 = S1 + vv * (f32x2){ck0[2], ck0[3]}, t2 = S2 + vv * (f32x2){ck1[0], ck1[1]}, t3 = S3 + vv * (f32x2){ck1[2], ck1[3]}; \
                const float sa = rowsum8(pq[0] + pq[1]); \
                const f32x2 nsa = {-sa, -sa}; \
                S0 = t0 + nsa * (f32x2){ca0[0], ca0[1]}; S1 = t1 + nsa * (f32x2){ca0[2], ca0[3]}; S2 = t2 + nsa * (f32x2){ca1[0], ca1[1]}; S3 = t3 + nsa * (f32x2){ca1[2], ca1[3]}; \
                f32x2 py = S0 * (f32x2){cr0[0], cr0[1]}; py += S1 * (f32x2){cr0[2], cr0[3]}; py += S2 * (f32x2){cr1[0], cr1[1]}; py += S3 * (f32x2){cr1[2], cr1[3]}; \
                YP[((s) & 1) * (TC * 256) + st * 256 + lt] = py[0] + py[1]; \
                if (st + 1 < TC) { ck0 = nk0; ck1 = nk1; ca0 = na0; ca1 = na1; cq0 = nq0; cq1 = nq1; cr0 = nr0; cr1 = nr1; cv = nv; } \
            } \
            { const f32x4 e0 = *(const f32x4*)(B), e1 = *(const f32x4*)(B + 4); \
              S0 *= (f32x2){e0[0], e0[1]}; S1 *= (f32x2){e0[2], e0[3]}; S2 *= (f32x2){e1[0], e1[1]}; S3 *= (f32x2){e1[2], e1[3]}; } \
        } while (0)
#define SC_UNPE(q) ((f32x4){bf_lo(pe[q].x), bf_hi(pe[q].x), bf_lo(pe[q].y), bf_hi(pe[q].y)})
#define SC_EWR(q, bi) do { f32x4 x_ = SC_UNPE(q); const int i4_ = sst & 3; \
        _Pragma("unroll") for (int j_ = 0; j_ < 4; ++j_) { const float y_ = __shfl_up(x_[j_], 16); x_[j_] += i4_ >= 1 ? y_ : 0.f; } \
        _Pragma("unroll") for (int j_ = 0; j_ < 4; ++j_) { const float y_ = __shfl_up(x_[j_], 32); x_[j_] += i4_ >= 2 ? y_ : 0.f; } \
        pin_ = x_; if (i4_ == 3) *(f32x4*)(EB + (bi) * 256 + (sst >> 2) * 64 + sj4) = x_; } while (0)
#define SC_CONVF(q, bi) do { float* B_ = bufs0 + (bi) * BUF; const float* G_ = EB + (bi) * 256 + sj4; const int w_ = sst >> 2; \
        const f32x4 r_ = (f32x4){bf_lo(pr[q].x), bf_hi(pr[q].x), bf_lo(pr[q].y), bf_hi(pr[q].y)}, k_ = (f32x4){bf_lo(pk[q].x), bf_hi(pk[q].x), bf_lo(pk[q].y), bf_hi(pk[q].y)}; \
        const f32x4 a_ = (f32x4){bf_lo(pa[q].x), bf_hi(pa[q].x), bf_lo(pa[q].y), bf_hi(pa[q].y)}, e_ = SC_UNPE(q); \
        f32x4 cum_ = pin_; \
        _Pragma("unroll") for (int g_ = 0; g_ < 3; ++g_) { const f32x4 gv_ = *(const f32x4*)(G_ + g_ * 64); const float m_ = g_ < w_ ? 1.0f : 0.0f; cum_ += gv_ * m_; } \
        const f32x4 cpr_ = cum_ - e_; \
        f32x4 pt_, pm_, ip_; \
        _Pragma("unroll") for (int j_ = 0; j_ < 4; ++j_) { pt_[j_] = __expf(-cum_[j_]); pm_[j_] = __expf(-cpr_[j_]); ip_[j_] = __expf(cum_[j_]); } \
        const f32x4 kk_ = k_ * lkkL_ * prn[q], kd_ = k_ * (1.0f + (a_ - 1.0f) * lkaL_), ka_ = kk_ * a_; \
        if (sst == TC - 1) *(f32x4*)(B_ + sj4) = pt_; \
        *(f32x4*)(B_ + 1 * TC * 64 + sst * 64 + sj4) = kd_ * ip_; *(f32x4*)(B_ + 2 * TC * 64 + sst * 64 + sj4) = ka_ * ip_; \
        *(f32x4*)(B_ + 3 * TC * 64 + sst * 64 + sj4) = kk_ * pm_; *(f32x4*)(B_ + 4 * TC * 64 + sst * 64 + sj4) = r_ * pt_; \
        if (lt < 128) *(f32x4*)(B_ + 5 * TC * 64 + vst * 32 + vi4) = (f32x4){bf_lo(pv[q].x), bf_hi(pv[q].x), bf_lo(pv[q].y), bf_hi(pv[q].y)}; } while (0)
    f32x2 S0 = {0.f, 0.f}, S1 = {0.f, 0.f}, S2 = {0.f, 0.f}, S3 = {0.f, 0.f};
    if (!handoff) {
#pragma unroll
        for (int q = 0; q < RD; ++q) SC_LOAD(q, (q < myslots ? q : lastslot));
        SC_CONV(0, 0);
        __syncthreads();
        for (int s0 = 0; s0 < maxslots; s0 += RD) {
#pragma unroll
          for (int q = 0; q < RD; ++q) {
            const int s = s0 + q;
            { const int ls = s + RD < myslots ? s + RD : lastslot; SC_LOAD(q, ls); }
            if (s < myslots) SC_COMPUTE(s, lat, ncu_sh, bufs, 0);
            if (s + 1 < myslots) SC_CONV((q + 1) % RD, (s + 1) & 1);
            __syncthreads();
          }
        }
    } else {
        const ScanDesc d0 = scan_decode(true, bid);
        if (hb == 0) {
            { const int i = d0.hf * 32 + rl; const float* sp = p.in[d0.dir ? 4 : 3] + ((size_t)(d0.b * 8 + d0.h) * 64 + i) * 64 + j8; const f32x4 a = *(const f32x4*)sp, b2 = *(const f32x4*)(sp + 4);
              S0 = (f32x2){a[0], a[1]}; S1 = (f32x2){a[2], a[3]}; S2 = (f32x2){b2[0], b2[1]}; S3 = (f32x2){b2[2], b2[3]}; }
            __syncthreads(); __syncthreads();
#pragma unroll 1
            for (int s = 0; s < maxslots; ++s) { SC_COMPUTE_F(s); __syncthreads(); }
        } else {
            const f32x4 lkkL_ = *(const f32x4*)(p.in[20] + d0.h * 64 + sj4), lkaL_ = *(const f32x4*)(p.in[21] + d0.h * 64 + sj4);
            const int sgn = d0.dir ? -1 : 1, cstep = sgn * 16 * 512;
            const int t0_ = d0.dir ? d0.base + d0.L - 1 - sst : d0.base + sst, tv0_ = d0.dir ? d0.base + d0.L - 1 - vst : d0.base + vst;
            const size_t o0_ = (size_t)t0_ * 512 + d0.h * 64 + sj4;
            const bf16_t* pR0 = Rr + o0_; const bf16_t* pK0 = Kr + o0_;
            const bf16_t* pA0 = (d0.dir ? (const bf16_t*)(p.ws + WS_AB) : (const bf16_t*)((unsigned char*)p.out + OUT_AF)) + o0_;
            const bf16_t* pE0 = (d0.dir ? (const bf16_t*)(p.ws + WS_EB) : (const bf16_t*)(p.ws + WS_EF)) + o0_;
            const float* pN0 = RN + t0_ * 8 + d0.h;
            const bf16_t* pV0 = Vr + (size_t)tv0_ * 512 + d0.h * 64 + d0.hf * 32 + vi4;
#define SC_LOADL(q, c) do { const long off_ = (long)(c) * cstep; \
                pr[q] = *(const u32x2*)(pR0 + off_); pk[q] = *(const u32x2*)(pK0 + off_); pa[q] = *(const u32x2*)(pA0 + off_); pe[q] = *(const u32x2*)(pE0 + off_); \
                prn[q] = pN0[(c) * (sgn * 128)]; pv[q] = *(const u32x2*)(pV0 + off_); } while (0)
            bf16_t* Yp0[2];
#pragma unroll
            for (int e2 = 0; e2 < 2; ++e2) { const int st_ = (lt + 256 * e2) >> 5; const int ty_ = d0.dir ? d0.base + d0.L - 1 - st_ : d0.base + st_;
                Yp0[e2] = (bf16_t*)(p.ws + (d0.dir ? WS_YB : WS_YF)) + (size_t)ty_ * 512 + d0.h * 64 + d0.hf * 32 + (lt & 31); }
#define SC_YRED(cs) do { const float* yp_ = YP + ((cs) & 1) * (TC * 256); \
                _Pragma("unroll") for (int e2 = 0; e2 < 2; ++e2) { const int e_ = lt + 256 * e2; \
                    const f32x4 u0 = *(const f32x4*)(yp_ + e_ * 8), u1 = *(const f32x4*)(yp_ + e_ * 8 + 4); \
                    Yp0[e2][(long)(cs) * cstep] = f2bf(((u0[0] + u0[1]) + (u0[2] + u0[3])) + ((u1[0] + u1[1]) + (u1[2] + u1[3]))); } } while (0)
            u32x2 c_r[2], c_k[2], c_a[2], c_e[2], c_v[2]; float c_n[2]; int c_h[2];
#define SC_CLOAD(ci, cs) do { const ScanDesc d_ = scan_decode(false, bid + ((cs) >> 4) * G); const int c_ = (cs) & 15; \
                const int t_ = SC_TOK(d_, c_ * TC + sst); const size_t o_ = (size_t)t_ * 512 + d_.h * 64 + sj4; \
                const bf16_t* Ar_ = d_.dir ? (const bf16_t*)(p.ws + WS_AB) : (const bf16_t*)((unsigned char*)p.out + OUT_AF); \
                const bf16_t* Er_ = d_.dir ? (const bf16_t*)(p.ws + WS_EB) : (const bf16_t*)(p.ws + WS_EF); \
                c_r[ci] = *(const u32x2*)(Rr + o_); c_k[ci] = *(const u32x2*)(Kr + o_); c_a[ci] = *(const u32x2*)(Ar_ + o_); c_e[ci] = *(const u32x2*)(Er_ + o_); c_n[ci] = RN[t_ * 8 + d_.h]; \
                c_h[ci] = d_.h; \
                { const int t2_ = SC_TOK(d_, c_ * TC + vst); c_v[ci] = *(const u32x2*)(Vr + (size_t)t2_ * 512 + d_.h * 64 + d_.hf * 32 + vi4); } } while (0)
#define SC_CCONV(ci, bi) do { float* B_ = bufs + (bi) * BUF; const f32x4 ckk_ = *(const f32x4*)(p.in[20] + c_h[ci] * 64 + sj4), cka_ = *(const f32x4*)(p.in[21] + c_h[ci] * 64 + sj4); \
                const f32x4 r_ = (f32x4){bf_lo(c_r[ci].x), bf_hi(c_r[ci].x), bf_lo(c_r[ci].y), bf_hi(c_r[ci].y)}, k_ = (f32x4){bf_lo(c_k[ci].x), bf_hi(c_k[ci].x), bf_lo(c_k[ci].y), bf_hi(c_k[ci].y)}; \
                const f32x4 a_ = (f32x4){bf_lo(c_a[ci].x), bf_hi(c_a[ci].x), bf_lo(c_a[ci].y), bf_hi(c_a[ci].y)}, e_ = (f32x4){bf_lo(c_e[ci].x), bf_hi(c_e[ci].x), bf_lo(c_e[ci].y), bf_hi(c_e[ci].y)}; \
                f32x4 w_; w_[0] = __expf(-e_[0]); w_[1] = __expf(-e_[1]); w_[2] = __expf(-e_[2]); w_[3] = __expf(-e_[3]); \
                const f32x4 kk_ = k_ * ckk_ * c_n[ci], kd_ = k_ * (1.0f + (a_ - 1.0f) * cka_), ka_ = kk_ * a_; \
                *(f32x4*)(B_ + 0 * TC * 64 + sst * 64 + sj4) = w_; *(f32x4*)(B_ + 1 * TC * 64 + sst * 64 + sj4) = kd_; *(f32x4*)(B_ + 2 * TC * 64 + sst * 64 + sj4) = ka_; \
                *(f32x4*)(B_ + 3 * TC * 64 + sst * 64 + sj4) = kk_; *(f32x4*)(B_ + 4 * TC * 64 + sst * 64 + sj4) = r_; \
                if (lt < 128) *(f32x4*)(B_ + 5 * TC * 64 + vst * 32 + vi4) = (f32x4){bf_lo(c_v[ci].x), bf_hi(c_v[ci].x), bf_lo(c_v[ci].y), bf_hi(c_v[ci].y)}; } while (0)
            float ykc0 = 0.f, ykc1 = 0.f;
#define SC_CQ(cs, QQ, CPAR) do { \
                const int c = (cs) & 15; const ScanDesc d = scan_decode(false, bid + ((cs) >> 4) * G); const int i = d.hf * 32 + rl; \
                if ((QQ) == 0) { ykc0 = 0.f; ykc1 = 0.f; if (c == 0) { S0 = (f32x2){0.f, 0.f}; S1 = S0; S2 = S0; S3 = S0; } } \
                const float* B = bufs + (CPAR) * BUF + j8 + (QQ) * 4 * 64; const float* Bv = bufs + (CPAR) * BUF + 5 * TC * 64 + rl + (QQ) * 4 * 32; \
                f32x4 cw0, cw1, ck0, ck1, ca0, ca1, cq0, cq1, cr0, cr1; float cv; \
                _Pragma("unroll") \
                for (int i4 = 0; i4 < 4; ++i4) { const int st = (QQ) * 4 + i4; \
                    SC_RD(i4, cw0, cw1, ck0, ck1, ca0, ca1, cq0, cq1, cr0, cr1, cv); \
                    f32x2 pq = S0 * (f32x2){cq0[0], cq0[1]}; pq += S1 * (f32x2){cq0[2], cq0[3]}; pq += S2 * (f32x2){cq1[0], cq1[1]}; pq += S3 * (f32x2){cq1[2], cq1[3]}; \
                    const f32x2 vv = {cv, cv}; \
                    f32x2 t0 = S0 * (f32x2){cw0[0], cw0[1]} + vv * (f32x2){ck0[0], ck0[1]}, t1 = S1 * (f32x2){cw0[2], cw0[3]} + vv * (f32x2){ck0[2], ck0[3]}; \
                    f32x2 t2 = S2 * (f32x2){cw1[0], cw1[1]} + vv * (f32x2){ck1[0], ck1[1]}, t3 = S3 * (f32x2){cw1[2], cw1[3]} + vv * (f32x2){ck1[2], ck1[3]}; \
                    const float sa = rowsum8(pq[0] + pq[1]); \
                    const f32x2 nsa = {-sa, -sa}; \
                    S0 = t0 + nsa * (f32x2){ca0[0], ca0[1]}; S1 = t1 + nsa * (f32x2){ca0[2], ca0[3]}; S2 = t2 + nsa * (f32x2){ca1[0], ca1[1]}; S3 = t3 + nsa * (f32x2){ca1[2], ca1[3]}; \
                    f32x2 py = S0 * (f32x2){cr0[0], cr0[1]}; py += S1 * (f32x2){cr0[2], cr0[3]}; py += S2 * (f32x2){cr1[0], cr1[1]}; py += S3 * (f32x2){cr1[2], cr1[3]}; \
                    const float y = rowsum8(py[0] + py[1]); \
                    if (st < 8) ykc0 = (jo == (st & 7)) ? y : ykc0; else ykc1 = (jo == (st & 7)) ? y : ykc1; \
                } \
                if ((QQ) == 3) { bf16_t* Yg = (bf16_t*)(p.ws + (d.dir ? WS_YB : WS_YF)); const int ta = SC_TOK(d, c * TC + jo), tb = SC_TOK(d, c * TC + 8 + jo); \
                    Yg[(size_t)ta * 512 + d.h * 64 + i] = f2bf(ykc0); Yg[(size_t)tb * 512 + d.h * 64 + i] = f2bf(ykc1); \
                    if (c == 15) { float* sp = p.out + (d.dir ? OUT_SB : OUT_SF) + ((size_t)(d.b * 8 + d.h) * 64 + i) * 64 + j8; \
                        *(f32x4*)sp = (f32x4){S0[0], S0[1], S1[0], S1[1]}; *(f32x4*)(sp + 4) = (f32x4){S2[0], S2[1], S3[0], S3[1]}; } } \
            } while (0)
            f32x4 pin_ = (f32x4){0.f, 0.f, 0.f, 0.f};
#pragma unroll
            for (int q = 0; q < RD; ++q) SC_LOADL(q, q);
            SC_CLOAD(0, 0); SC_CLOAD(1, 1);
            SC_EWR(0, 0);
            SC_CCONV(0, 0);
            __syncthreads();
            SC_CONVF(0, 0);
            SC_LOADL(0, 4);
            SC_EWR(1, 1);
            __syncthreads();
            for (int s0 = 0; s0 < maxslots; s0 += 8) {
#pragma unroll
              for (int h8 = 0; h8 < 8; ++h8) {
                const int s = s0 + h8, cs = s >> 2;
                if (s > 0) SC_YRED(s - 1);
                if (s + 1 < maxslots) SC_CONVF((h8 + 1) & 3, (h8 + 1) & 1);
                SC_EWR((h8 + 2) & 3, h8 & 1);
                { const int ls = s + 5 < maxslots ? s + 5 : maxslots - 1; SC_LOADL((h8 + 1) & 3, ls); }
                SC_CQ(cs, h8 & 3, h8 >> 2);
                if ((h8 & 3) == 0) { const int lc = cs + 2 < 64 ? cs + 2 : 63; SC_CLOAD(h8 >> 2, lc); }
                if ((h8 & 3) == 2) { if (cs + 1 < 64) SC_CCONV((h8 >> 2) ^ 1, (h8 >> 2) ^ 1); }
                __syncthreads();
              }
            }
            SC_YRED(maxslots - 1);
#undef SC_LOADL
#undef SC_YRED
#undef SC_CLOAD
#undef SC_CCONV
#undef SC_CQ
        }
    }
#undef SC_EWR
#undef SC_CONVF
#undef SC_UNPE
#undef SC_COMPUTE_F
#undef SC_TOK
#undef SC_LOADX
#undef SC_CONVX
#undef SC_LOAD
#undef SC_CONV
#undef SC_RD
#undef SC_COMPUTE
}

__device__ void phase_combine(const Params& p) {
    const bf16_t* YF = (const bf16_t*)(p.ws + WS_YF); const bf16_t* YB = (const bf16_t*)(p.ws + WS_YB);
    const bf16_t* Vr = (const bf16_t*)((unsigned char*)p.out + OUT_V); bf16_t* MIX = (bf16_t*)(p.ws + WS_MIX); const float* SBv = (const float*)(p.ws + WS_SB);
    for (int item0 = blockIdx.x * 512 + threadIdx.x; item0 < T_ALL * 128; item0 += gridDim.x * 1024) {
        f32x4 yv[2], lw[2], lb[2], vv[2], gv[2]; float sb[2];
#pragma unroll
        for (int u = 0; u < 2; ++u) { const int item = item0 + u * gridDim.x * 512, t = item >> 7, c = (item & 127) * 4, h = c >> 6;
            yv[u] = ld_bf4(YF + (size_t)t * 512 + c) + ld_bf4(YB + (size_t)t * 512 + c);
            lw[u] = *(const f32x4*)(p.in[23] + c); lb[u] = *(const f32x4*)(p.in[24] + c);
            vv[u] = ld_bf4(Vr + (size_t)t * 512 + c); gv[u] = ld_bf4(MIX + (size_t)t * DM + c); sb[u] = SBv[t * 8 + h]; }
#pragma unroll
        for (int u = 0; u < 2; ++u) { const int item = item0 + u * gridDim.x * 512, t = item >> 7, c = (item & 127) * 4;
            const f32x4 y = yv[u];
            const float mean = rowsum16(y[0] + y[1] + y[2] + y[3]) * (1.0f / 64.0f);
            const f32x4 d = y - mean;
            const float var = rowsum16(d[0] * d[0] + d[1] * d[1] + d[2] * d[2] + d[3] * d[3]) * (1.0f / 64.0f);
            const float rstd = rsqrtf(var + 64.0f * 1e-5f);
            st_bf4(MIX + (size_t)t * DM + c, (d * rstd * lw[u] + lb[u] + sb[u] * vv[u]) * gv[u]); }
    }
}

__device__ void phase_dbg_dump(const Params& p) {
    const unsigned* w = (const unsigned*)p.ws; unsigned* o = (unsigned*)p.out;
    const size_t NO = (size_t)T_ALL * DM + 2u * 32 * 8 * 64 * 64;
    for (size_t i = (size_t)blockIdx.x * 512 + threadIdx.x; i < NO; i += (size_t)gridDim.x * 512) {
        const bool useo = (i < (size_t)T_ALL * DM) ? (DBG_STOP >= 3 && !(P3_SKIP & 1)) : (DBG_STOP >= 4);
        unsigned v = (useo ? o[i] : 0u) ^ w[i] ^ (w[i + NO] * 3u) ^ (w[i + 2 * NO] * 5u);
        v ^= v >> 16; ((float*)o)[i] = (float)(v & 0xFFFFu);
    }
}
#define XB_TMO      128
#define XB_XCNT(j)  (256  + 64 * (j))
#define XB_XSUB(j)  (1280 + 64 * (j))
#define XB_XGEN(j)  (2304 + 64 * (j))
#define XB_TOP      3328
#define XB_TOPGEN   3392
#define XCD_BAR_WORDS 3456
#define XB_SPIN_CAP (1u << 18)
__device__ __forceinline__ unsigned xb_ld(unsigned* p)              { return __hip_atomic_load(p, __ATOMIC_RELAXED, __HIP_MEMORY_SCOPE_AGENT); }
__device__ __forceinline__ unsigned xb_add(unsigned* p, unsigned v) { return __hip_atomic_fetch_add(p, v, __ATOMIC_RELAXED, __HIP_MEMORY_SCOPE_AGENT); }
__device__ __forceinline__ unsigned xb_xcc_id() { return (unsigned)__builtin_amdgcn_s_getreg((3 << 11) | 20) & 0xFu; }
#define XB_SPIN(cond, bar) do { unsigned _sp = 0; while (cond) { __builtin_amdgcn_s_sleep(1); \
    if ((++_sp & 255u) == 0u) { if (xb_ld(&(bar)[XB_TMO])) break; if (_sp > XB_SPIN_CAP) { atomicAdd(&(bar)[XB_TMO], 1u); break; } } } } while (0)
struct XcdBarrier { unsigned* bar; unsigned x; volatile LAS unsigned* st; };
__device__ __forceinline__ XcdBarrier xcd_barrier_post(unsigned* bar, volatile LAS unsigned* st) {
    XcdBarrier b; b.bar = bar; b.x = xb_xcc_id(); b.st = st;
    if (threadIdx.x == 0) (void)xb_add(&bar[XB_XCNT(b.x)], 1u);
    return b;
}
__device__ __forceinline__ void xcd_barrier_complete(unsigned* bar, unsigned x, unsigned& nloc, unsigned& nx) {
    const unsigned G = gridDim.x * gridDim.y * gridDim.z;
    unsigned sum, cnt, mine, sp = 0u;
    for (;;) {
        sum = 0u; cnt = 0u; mine = 0u;
#pragma unroll
        for (unsigned j = 0; j < 16; ++j) { const unsigned c = xb_ld(&bar[XB_XCNT(j)]); sum += c; cnt += (c > 0u) ? 1u : 0u; mine = (j == x) ? c : mine; }
        if (sum == G) break;
        __builtin_amdgcn_s_sleep(1);
        if ((++sp & 255u) == 0u) { if (xb_ld(&bar[XB_TMO])) break; if (sp > XB_SPIN_CAP) { atomicAdd(&bar[XB_TMO], 1u); break; } }
    }
    nloc = mine > 0u ? mine : 1u; nx = cnt > 0u ? cnt : 1u;
}
__device__ __forceinline__ void xcd_barrier(const XcdBarrier& b) {
    asm volatile("s_waitcnt vmcnt(0)" ::: "memory");
    __syncthreads();
    if (threadIdx.x == 0) {
        unsigned* bar = b.bar;
        __builtin_amdgcn_s_waitcnt(0);
        unsigned nloc = b.st[0], nx = b.st[1];
        if (nloc == 0u) { xcd_barrier_complete(bar, b.x, nloc, nx); b.st[0] = nloc; b.st[1] = nx; }
        const unsigned old = xb_add(&bar[XB_XSUB(b.x)], 1u);
        const unsigned gen = old / nloc;
        if (old + 1u == (gen + 1u) * nloc) {
            __builtin_amdgcn_fence(__ATOMIC_RELEASE, "agent");
            asm volatile("s_waitcnt vmcnt(0)" ::: "memory");
            const unsigned og = xb_add(&bar[XB_TOP], 1u);
            const unsigned tg = og / nx;
            if (og + 1u == (tg + 1u) * nx) xb_add(&bar[XB_TOPGEN], 1u);
            else XB_SPIN(xb_ld(&bar[XB_TOPGEN]) == tg, bar);
            __builtin_amdgcn_fence(__ATOMIC_ACQUIRE, "agent");
            xb_add(&bar[XB_XGEN(b.x)], 1u);
            asm volatile("s_waitcnt vmcnt(0)" ::: "memory");
        } else {
            XB_SPIN(xb_ld(&bar[XB_XGEN(b.x)]) == gen, bar);
            __builtin_amdgcn_fence(__ATOMIC_ACQUIRE, "agent");
            asm volatile("s_waitcnt vmcnt(0)" ::: "memory");
        }
    }
    __syncthreads();
}

__global__ void __launch_bounds__(512, 2) fwd_megakernel(Params p) {
    extern __shared__ __attribute__((aligned(16))) unsigned char shm[];
    cg::grid_group grid = cg::this_grid();
    volatile LAS unsigned* xbst = (volatile LAS unsigned*)((LAS unsigned char*)shm + 131072);
    if (threadIdx.x == 0) { xbst[0] = 0u; xbst[1] = 0u; }
    __syncthreads();
    const XcdBarrier xb = xcd_barrier_post((unsigned*)(p.ws + WS_BAR), xbst);
#define RUN(k) (((PH_MASK >> (k)) & 1) && p.ph_lo <= (k) && (k) < p.ph_hi && (DBG_STOP < 0 || (k) <= DBG_STOP))
#ifndef SYNC_REPS
#define SYNC_REPS 1
#endif
#define SEAM(k) do { if (p.ph_lo <= (k) && (k) + 1 < p.ph_hi) { __syncthreads(); xcd_barrier(xb); } } while (0)
    if (p.ph_hi > 1000) grid.sync();
    if (RUN(0)) phase_setup(p, shm);
    SEAM(0);
    if (RUN(1)) phase_norm<0>(p);
    SEAM(1);
    if (RUN(2)) { pg8::Gemm g{(const bf16_t*)(p.ws + WS_H), (const bf16_t*)(p.ws + WS_WIN), T_ALL, ZPAD, 1024}; pg8::StaticOrder S; S.init(T_ALL, ZPAD, (int)gridDim.x, (int)blockIdx.x);
                  EpiZ E{(bf16_t*)(p.ws + WS_Z)}; pg8::gemm_phase((LAS unsigned char*)shm, g, S, E); }
    SEAM(2);
    if (RUN(3)) phase_prep<0>(p, shm);
    if ((DUP_MASK >> 3) & 1) { __syncthreads(); phase_prep<P3DUP_SKIP>(p, shm); }
    SEAM(3);
    if (RUN(4)) phase_scan(p, shm);
    if ((DUP_MASK >> 4) & 1) { __syncthreads(); phase_scan(p, shm); }
    SEAM(4);
    if (RUN(5)) phase_combine(p);
    SEAM(5);
    if (RUN(6)) { pg8::Gemm g{(const bf16_t*)(p.ws + WS_MIX), (const bf16_t*)(p.ws + WS_WOUT), T_ALL, 1024, 1024}; pg8::StaticOrder S; S.init(T_ALL, 1024, (int)gridDim.x, (int)blockIdx.x);
                  EpiX1 E{p, (bf16_t*)(p.ws + WS_H)}; pg8::gemm_phase((LAS unsigned char*)shm, g, S, E); }
    SEAM(6);
    if (RUN(7)) phase_norm<1>(p);
    SEAM(7);
    if (RUN(8)) { pg8::Gemm g{(const bf16_t*)(p.ws + WS_MIX), (const bf16_t*)(p.ws + WS_W1), T_ALL, DFF, 1024}; pg8::StaticOrder S; S.init(T_ALL, DFF, (int)gridDim.x, (int)blockIdx.x);
                  EpiHid E{(bf16_t*)(p.ws + WS_HID)}; pg8::gemm_phase((LAS unsigned char*)shm, g, S, E);
                  if ((DUP_MASK >> 8) & 1) { __syncthreads(); pg8::gemm_phase((LAS unsigned char*)shm, g, S, E); } }
    SEAM(8);
    if (RUN(9)) { pg8::Gemm g{(const bf16_t*)(p.ws + WS_HID), (const bf16_t*)(p.ws + WS_W2), T_ALL, 1024, DFF}; pg8::StaticOrder S; S.init(T_ALL, 1024, (int)gridDim.x, (int)blockIdx.x);
                  EpiX2 E{p, (const bf16_t*)(p.ws + WS_H), (bf16_t*)(p.ws + WS_MIX)}; pg8::gemm_phase((LAS unsigned char*)shm, g, S, E); }
    SEAM(9);
    if (RUN(10)) phase_norm<2>(p);
    if (DBG_STOP >= 0 && p.ph_lo <= 11 && 11 < p.ph_hi) phase_dbg_dump(p);
}

extern "C" void kernel_launch(void* const* d_in, const int* in_sizes, int n_in, void* d_out, int out_size, void* d_ws, size_t ws_size, hipStream_t stream) {
    static int grid_blocks = 0;
    if (grid_blocks == 0) {
        int dev = 0, cus = 0, per_cu = 0;
        hipGetDevice(&dev);
        hipDeviceGetAttribute(&cus, hipDeviceAttributeMultiprocessorCount, dev);
        if (hipFuncSetAttribute((const void*)fwd_megakernel, hipFuncAttributeMaxDynamicSharedMemorySize, LDS_BYTES) != hipSuccess) fprintf(stderr, "hipFuncSetAttribute failed\n");
        if (hipOccupancyMaxActiveBlocksPerMultiprocessor(&per_cu, (const void*)fwd_megakernel, 512, LDS_BYTES) != hipSuccess || per_cu < 1) { fprintf(stderr, "occupancy query failed (%d)\n", per_cu); per_cu = 1; }
        if (per_cu > 1) per_cu = 1;
        grid_blocks = cus * per_cu;
        if (ws_size < WS_NEED || n_in != 32) fprintf(stderr, "kernel_launch: ws_size %zu < %zu or n_in %d != 32\n", ws_size, (size_t)WS_NEED, n_in);
    }
    Params p{};
    for (int i = 0; i < 32; ++i) p.in[i] = (const float*)d_in[i];
    p.out = (float*)d_out; p.ws = (unsigned char*)d_ws;
#if MK_MULTI
    for (int ph = 0; ph < (DBG_STOP >= 0 ? 12 : 11); ++ph) { p.ph_lo = ph; p.ph_hi = ph + 1; hipLaunchKernelGGL(fwd_megakernel, dim3(grid_blocks), dim3(512), LDS_BYTES, stream, p); }
#else
    p.ph_lo = 0; p.ph_hi = 11;
    if (hipMemsetAsync((unsigned char*)d_ws + WS_BAR, 0, XCD_BAR_WORDS * sizeof(unsigned), stream) != hipSuccess) fprintf(stderr, "barrier memset failed\n");
    void* args[] = {&p};
    hipError_t e = hipLaunchCooperativeKernel((const void*)fwd_megakernel, dim3(grid_blocks), dim3(512), args, LDS_BYTES, stream);
    if (e != hipSuccess) fprintf(stderr, "cooperative launch failed: %s (grid %d)\n", hipGetErrorString(e), grid_blocks);
#endif
}
```

```cpp
#include <hip/hip_runtime.h>
#include <hip/hip_cooperative_groups.h>
#include <cstdio>
namespace cg = cooperative_groups;

#ifndef MK_MULTI
#define MK_MULTI 0
#endif
#ifndef PH_MASK
#define PH_MASK 0x7ff
#endif
#ifndef P3_SKIP
#define P3_SKIP 0
#endif
#ifndef DUP_MASK
#define DUP_MASK 0
#endif
#ifndef P3DUP_SKIP
#define P3DUP_SKIP 0
#endif
#ifndef DBG_STOP
#define DBG_STOP -1
#endif

typedef unsigned short bf16_t;
typedef short bf16x8 __attribute__((ext_vector_type(8)));
typedef float f32x4 __attribute__((ext_vector_type(4)));
typedef unsigned u32x4 __attribute__((ext_vector_type(4)));
typedef unsigned u32x2 __attribute__((ext_vector_type(2)));
#define LAS __attribute__((address_space(3)))

constexpr int T_CTX = 8192, T_ALL = 40960, DM = 1024, ZC = 3456, ZPAD = 3584, DFF = 4096;
constexpr size_t MiB = 1u << 20;
constexpr size_t WS_MOD = 0, WS_RN = 1 * MiB, WS_SB = 5 * MiB / 2, WS_LORA = 4 * MiB, WS_WIN = 5 * MiB, WS_WOUT = 12 * MiB, WS_W1 = 14 * MiB, WS_W2 = 22 * MiB;
constexpr size_t WS_H = 32 * MiB, WS_AB = 32 * MiB, WS_EF = 72 * MiB, WS_MIX = 112 * MiB, WS_Z = 192 * MiB, WS_YF = 192 * MiB, WS_YB = 272 * MiB, WS_HID = 192 * MiB, WS_EB = 462 * MiB;
constexpr size_t WS_NEED = 512 * MiB;
constexpr size_t OUT_R = 0, OUT_K = 40 * MiB, OUT_V = 80 * MiB, OUT_AF = 120 * MiB;
constexpr size_t OUT_SF = (size_t)T_ALL * DM, OUT_SB = OUT_SF + 32 * 8 * 64 * 64;
constexpr int LDS_BYTES = 131072 + 16;
constexpr size_t WS_BAR = 15 * MiB / 4;

struct Params { const float* in[32]; float* out; unsigned char* ws; int ph_lo, ph_hi; };

typedef __bf16 bf16x2_t __attribute__((ext_vector_type(2)));
typedef float f32x2 __attribute__((ext_vector_type(2)));
__device__ __forceinline__ unsigned cvt_pk_bf16(float lo, float hi) { f32x2 v = {lo, hi}; bf16x2_t b = __builtin_convertvector(v, bf16x2_t); return __builtin_bit_cast(unsigned, b); }
__device__ __forceinline__ bf16_t f2bf(float x) { return (bf16_t)(cvt_pk_bf16(x, 0.f) & 0xffffu); }
__device__ __forceinline__ float bf_lo(unsigned u) { return __uint_as_float(u << 16); }
__device__ __forceinline__ float bf_hi(unsigned u) { return __uint_as_float(u & 0xffff0000u); }
__device__ __forceinline__ float sigmoidf_(float x) { return __builtin_amdgcn_rcpf(1.0f + __expf(-x)); }
__device__ __forceinline__ float tanhf_(float x) { return 1.0f - 2.0f * __builtin_amdgcn_rcpf(__expf(2.0f * x) + 1.0f); }
template <int CTRL> __device__ __forceinline__ float dpp_(float x) { return __builtin_bit_cast(float, __builtin_amdgcn_mov_dpp(__builtin_bit_cast(int, x), CTRL, 0xf, 0xf, true)); }
__device__ __forceinline__ float rowsum16(float x) { x += dpp_<0xB1>(x); x += dpp_<0x4E>(x); x += dpp_<0x141>(x); x += dpp_<0x128>(x); return x; }
__device__ __forceinline__ float wavesum(float x) { x = rowsum16(x); x += __shfl_xor(x, 16); x += __shfl_xor(x, 32); return x; }
__device__ __forceinline__ const float* xrow(const Params& p, int r) { return r < T_CTX ? p.in[0] + (size_t)r * DM : p.in[1] + (size_t)(r - T_CTX) * DM; }
__device__ __forceinline__ f32x4 ld_bf4(const bf16_t* src) { const u32x2 w = *(const u32x2*)src; return (f32x4){bf_lo(w.x), bf_hi(w.x), bf_lo(w.y), bf_hi(w.y)}; }
__device__ __forceinline__ int mod_index(int r) { return r < T_CTX ? 0 : 1 + ((r - T_CTX) >> 12); }

namespace pg8 {
constexpr int BM = 256, BK = 64, HALF = 128, HTB = HALF * BK * 2, NXCD = 8, WGM = 8;
__device__ __forceinline__ int lds_byte(int r, int c) { const int st = (r >> 4) * 2 + (c >> 5), rr = r & 15, cc = c & 31, ob = rr * 64 + cc * 2; return st * 1024 + (ob ^ (((ob >> 9) & 1) << 5)); }
__device__ __forceinline__ void stage_rc(int b, int& R, int& C) { const int st = b / 1024, sb = b % 1024, swz = sb ^ (((sb >> 9) & 1) << 5); R = (st >> 1) * 16 + swz / 64; C = (st & 1) * 32 + (swz % 64) / 2; }
__device__ __forceinline__ int perm32(int rho) { const int n = rho >> 4, i = rho & 15; return 8 * (i >> 2) + 4 * n + (i & 3); }
struct Unit { int pm, pn; };
struct Gemm { const bf16_t* A; const bf16_t* Bt; int M, N, K; };
struct StaticOrder {
    int nM, nN, nwg, G, c;
    __device__ void init(int M, int N, int G_, int c_) { nM = M / BM; nN = N / BM; nwg = nM * nN; G = G_; c = c_; }
    __device__ bool next(int i, Unit& u) const {
        const long L = (long)i * G + c; if (L >= nwg) return false;
        int wgid = (int)L; { const int q = nwg / NXCD, r = nwg % NXCD, xcd = wgid % NXCD, off = wgid / NXCD; wgid = (xcd < r ? xcd * (q + 1) : r * (q + 1) + (xcd - r) * q) + off; }
        const int nig = WGM * nN, gid = wgid / nig, fm = gid * WGM, gsz = (nM - fm) < WGM ? (nM - fm) : WGM;
        u.pm = fm + ((wgid % nig) % gsz); u.pn = (wgid % nig) / gsz; return true;
    }
};

template <class Epi>
__device__ __forceinline__ void gemm_phase(LAS unsigned char* lds, const Gemm g, const StaticOrder& S, const Epi& E) {
    const int tid = threadIdx.x, wid = __builtin_amdgcn_readfirstlane(tid >> 6), lane = tid & 63, wr = wid >> 2, wc = wid & 3, fr = lane & 15, fq = lane >> 4;
    const int K = g.K, nt = K / BK;
    unsigned voffA[2], voffB[2];
#pragma unroll
    for (int i = 0; i < 2; ++i) { int R, C; stage_rc(tid * 16 + i * 8192, R, C); const int Rb = Epi::PERM ? ((R & ~31) + perm32(R & 31)) : R;
        voffA[i] = (unsigned)(R * K + C) * 2u; voffB[i] = (unsigned)(Rb * K + C) * 2u; }
    const size_t kstep = (size_t)(BK * 2);
    const size_t hstep = (size_t)HALF * K * 2;
    const size_t tstep = 2 * hstep;
    const unsigned ldsw = (unsigned)wid * 1024u;
    const int aoff = lds_byte(wr * 64 + fr, fq * 8), boff = lds_byte(wc * 32 + fr, fq * 8);
#define PG8_SA(b, h) (((b) * 2 + (h)) * HTB)
#define PG8_SB(b, h) ((4 + (b) * 2 + (h)) * HTB)
#define PG8_STAGE(bufoff, gbase, voff) do { _Pragma("unroll") for (int _i = 0; _i < 2; ++_i) \
        __builtin_amdgcn_global_load_lds((const unsigned*)((const char*)(gbase) + (voff)[_i]), (LAS unsigned*)(lds + (bufoff) + ldsw + _i * 8192), 16, 0, 0); } while (0)
#define PG8_LDA(dst, b, h) do { _Pragma("unroll") for (int m = 0; m < 4; ++m) _Pragma("unroll") for (int k = 0; k < 2; ++k) dst[m][k] = *(const LAS bf16x8*)(lds + PG8_SA(b, h) + aoff + m * 2048 + k * 1024); } while (0)
#define PG8_LDB(dst, b, h) do { _Pragma("unroll") for (int n = 0; n < 2; ++n) _Pragma("unroll") for (int k = 0; k < 2; ++k) dst[n][k] = *(const LAS bf16x8*)(lds + PG8_SB(b, h) + boff + n * 2048 + k * 1024); } while (0)
#define PG8_MMA(ai, bj, At, Bt) do { __builtin_amdgcn_s_setprio(1); _Pragma("unroll") for (int m = 0; m < 4; ++m) _Pragma("unroll") for (int n = 0; n < 2; ++n) _Pragma("unroll") for (int k = 0; k < 2; ++k) \
        acc[ai][bj][m][n] = __builtin_amdgcn_mfma_f32_16x16x32_bf16(Bt[n][k], At[m][k], acc[ai][bj][m][n], 0, 0, 0); __builtin_amdgcn_s_setprio(0); } while (0)
#define PG8_WAIT_V(n) asm volatile("s_waitcnt vmcnt(" #n ")" ::: "memory")
#define PG8_WAIT_L(n) asm volatile("s_waitcnt lgkmcnt(" #n ")" ::: "memory")
#define PG8_BAR __builtin_amdgcn_s_barrier()
#define PG8_SCHED __builtin_amdgcn_sched_barrier(0)
    Unit cur, nxt; int ui = 0;
    if (!S.next(0, cur)) return;
    f32x4 acc[2][2][4][2];
#pragma unroll
    for (int a = 0; a < 2; ++a)
#pragma unroll
        for (int b = 0; b < 2; ++b)
#pragma unroll
            for (int m = 0; m < 4; ++m)
#pragma unroll
                for (int n = 0; n < 2; ++n) acc[a][b][m][n] = (f32x4){0.f, 0.f, 0.f, 0.f};
    bf16x8 At[4][2], B0[2][2], B1[2][2];
    const char* cA = (const char*)g.A + (size_t)cur.pm * tstep; const char* cB = (const char*)g.Bt + (size_t)cur.pn * tstep;
    PG8_STAGE(PG8_SB(0, 0), cB, voffB); PG8_STAGE(PG8_SA(0, 0), cA, voffA); PG8_STAGE(PG8_SB(0, 1), cB + hstep, voffB); PG8_STAGE(PG8_SA(0, 1), cA + hstep, voffA);
    if (wr == 1) PG8_BAR;
    PG8_WAIT_V(4); PG8_BAR;
    PG8_STAGE(PG8_SB(1, 0), cB + kstep, voffB); PG8_STAGE(PG8_SA(1, 0), cA + kstep, voffA); PG8_STAGE(PG8_SB(1, 1), cB + hstep + kstep, voffB);
    PG8_WAIT_V(6); PG8_BAR;
    for (;;) {
        const bool has_next = S.next(ui + 1, nxt);
        const char* nA = has_next ? (const char*)g.A + (size_t)nxt.pm * tstep : cA; const char* nB = has_next ? (const char*)g.Bt + (size_t)nxt.pn * tstep : cB;
        for (int t = 0; t < nt; t += 2) {
            const bool last = (t == nt - 2);
            const char* a1 = cA + (size_t)(t + 1) * kstep;
            const char* a2 = last ? nA : cA + (size_t)(t + 2) * kstep; const char* b2 = last ? nB : cB + (size_t)(t + 2) * kstep;
            const char* a3 = a2 + kstep; const char* b3 = b2 + kstep;
            PG8_LDB(B0, 0, 0); PG8_SCHED; PG8_LDA(At, 0, 0); PG8_STAGE(PG8_SA(1, 1), a1 + hstep, voffA);
            PG8_WAIT_L(8); PG8_BAR; PG8_WAIT_L(0); PG8_MMA(0, 0, At, B0); PG8_BAR; PG8_SCHED;
            PG8_LDB(B1, 0, 1); PG8_STAGE(PG8_SB(0, 0), b2, voffB);
            PG8_BAR; PG8_WAIT_L(0); PG8_MMA(0, 1, At, B1); PG8_BAR;
            PG8_LDA(At, 0, 1); PG8_STAGE(PG8_SA(0, 0), a2, voffA);
            PG8_BAR; PG8_WAIT_L(0); PG8_MMA(1, 0, At, B0); PG8_BAR; PG8_SCHED;
            PG8_STAGE(PG8_SB(0, 1), b2 + hstep, voffB);
            PG8_WAIT_V(6); PG8_BAR; PG8_MMA(1, 1, At, B1); PG8_BAR;
            PG8_LDB(B0, 1, 0); PG8_SCHED; PG8_LDA(At, 1, 0); PG8_STAGE(PG8_SA(0, 1), a2 + hstep, voffA);
            PG8_WAIT_L(8); PG8_BAR; PG8_WAIT_L(0); PG8_MMA(0, 0, At, B0); PG8_BAR; PG8_SCHED;
            PG8_LDB(B1, 1, 1); PG8_STAGE(PG8_SB(1, 0), b3, voffB);
            PG8_BAR; PG8_WAIT_L(0); PG8_MMA(0, 1, At, B1); PG8_BAR;
            PG8_LDA(At, 1, 1); PG8_STAGE(PG8_SA(1, 0), a3, voffA);
            PG8_BAR; PG8_WAIT_L(0); PG8_MMA(1, 0, At, B0); PG8_BAR; PG8_SCHED;
            PG8_STAGE(PG8_SB(1, 1), b3 + hstep, voffB);
            PG8_WAIT_V(6); PG8_BAR; PG8_MMA(1, 1, At, B1); PG8_BAR;
        }
        E(acc, cur, wr, wc, fr, fq);
        if (!has_next) break;
#pragma unroll
        for (int a = 0; a < 2; ++a)
#pragma unroll
            for (int b = 0; b < 2; ++b)
#pragma unroll
                for (int m = 0; m < 4; ++m)
#pragma unroll
                    for (int n = 0; n < 2; ++n) acc[a][b][m][n] = (f32x4){0.f, 0.f, 0.f, 0.f};
        cur = nxt; cA = nA; cB = nB; ++ui;
    }
    PG8_WAIT_V(0);
    if (wr == 0) PG8_BAR;
    PG8_BAR;
#undef PG8_SA
#undef PG8_SB
#undef PG8_STAGE
#undef PG8_LDA
#undef PG8_LDB
#undef PG8_MMA
#undef PG8_WAIT_V
#undef PG8_WAIT_L
#undef PG8_BAR
#undef PG8_SCHED
}
}

struct EpiZ {
    static constexpr bool PERM = true;
    bf16_t* O;
    __device__ __forceinline__ void operator()(const f32x4 (&acc)[2][2][4][2], const pg8::Unit& u, int wr, int wc, int fr, int fq) const {
        const int row0 = u.pm * 256 + wr * 64 + fr, col0 = u.pn * 256 + wc * 32 + 8 * fq;
#pragma unroll
        for (int ai = 0; ai < 2; ++ai)
#pragma unroll
            for (int m = 0; m < 4; ++m) { bf16_t* rowp = O + (size_t)(row0 + ai * 128 + m * 16) * ZC + col0;
#pragma unroll
                for (int bj = 0; bj < 2; ++bj) if (u.pn * 256 + bj * 128 < ZC) { const f32x4 v0 = acc[ai][bj][m][0], v1 = acc[ai][bj][m][1];
                    u32x4 w; w.x = cvt_pk_bf16(v0[0], v0[1]); w.y = cvt_pk_bf16(v0[2], v0[3]); w.z = cvt_pk_bf16(v1[0], v1[1]); w.w = cvt_pk_bf16(v1[2], v1[3]);
                    *(u32x4*)(rowp + bj * 128) = w; } }
    }
};
struct EpiHid {
    static constexpr bool PERM = true;
    bf16_t* O;
    __device__ __forceinline__ void operator()(const f32x4 (&acc)[2][2][4][2], const pg8::Unit& u, int wr, int wc, int fr, int fq) const {
        const int row0 = u.pm * 256 + wr * 64 + fr, col0 = u.pn * 256 + wc * 32 + 8 * fq;
#pragma unroll
        for (int ai = 0; ai < 2; ++ai)
#pragma unroll
            for (int m = 0; m < 4; ++m) { bf16_t* rowp = O + (size_t)(row0 + ai * 128 + m * 16) * DFF + col0;
#pragma unroll
                for (int bj = 0; bj < 2; ++bj) { f32x4 v0 = acc[ai][bj][m][0], v1 = acc[ai][bj][m][1];
#pragma unroll
                    for (int j = 0; j < 4; ++j) { const float a = fmaxf(v0[j], 0.f), b = fmaxf(v1[j], 0.f); v0[j] = a * a; v1[j] = b * b; }
                    u32x4 w; w.x = cvt_pk_bf16(v0[0], v0[1]); w.y = cvt_pk_bf16(v0[2], v0[3]); w.z = cvt_pk_bf16(v1[0], v1[1]); w.w = cvt_pk_bf16(v1[2], v1[3]);
                    *(u32x4*)(rowp + bj * 128) = w; } }
    }
};
struct EpiX1 {
    static constexpr bool PERM = true;
    Params p; bf16_t* O;
    __device__ __forceinline__ void operator()(const f32x4 (&acc)[2][2][4][2], const pg8::Unit& u, int wr, int wc, int fr, int fq) const {
        const int row0 = u.pm * 256 + wr * 64 + fr, col0 = u.pn * 256 + wc * 32 + 8 * fq;
        const float* gate = (const float*)(p.ws + WS_MOD) + mod_index(u.pm * 256) * 6144 + 2 * 1024 + col0;
        f32x4 gv[2][2];
#pragma unroll
        for (int bj = 0; bj < 2; ++bj)
#pragma unroll
            for (int n = 0; n < 2; ++n) gv[bj][n] = *(const f32x4*)(gate + bj * 128 + 4 * n);
#pragma unroll
        for (int ai = 0; ai < 2; ++ai) {
            f32x4 bv[4][2][2];
#pragma unroll
            for (int m = 0; m < 4; ++m) { const float* brow = xrow(p, row0 + ai * 128 + m * 16) + col0;
#pragma unroll
                for (int bj = 0; bj < 2; ++bj)
#pragma unroll
                    for (int n = 0; n < 2; ++n) bv[m][bj][n] = *(const f32x4*)(brow + bj * 128 + 4 * n); }
#pragma unroll
            for (int m = 0; m < 4; ++m) { bf16_t* orow = O + (size_t)(row0 + ai * 128 + m * 16) * DM + col0;
#pragma unroll
                for (int bj = 0; bj < 2; ++bj) { const f32x4 v0 = bv[m][bj][0] + gv[bj][0] * acc[ai][bj][m][0], v1 = bv[m][bj][1] + gv[bj][1] * acc[ai][bj][m][1];
                    u32x4 w; w.x = cvt_pk_bf16(v0[0], v0[1]); w.y = cvt_pk_bf16(v0[2], v0[3]); w.z = cvt_pk_bf16(v1[0], v1[1]); w.w = cvt_pk_bf16(v1[2], v1[3]);
                    *(u32x4*)(orow + bj * 128) = w; } }
        }
    }
};
struct EpiX2 {
    static constexpr bool PERM = true;
    Params p; const bf16_t* X1; bf16_t* O;
    __device__ __forceinline__ void operator()(const f32x4 (&acc)[2][2][4][2], const pg8::Unit& u, int wr, int wc, int fr, int fq) const {
        const int row0 = u.pm * 256 + wr * 64 + fr, col0 = u.pn * 256 + wc * 32 + 8 * fq;
        const float* gate = (const float*)(p.ws + WS_MOD) + mod_index(u.pm * 256) * 6144 + 5 * 1024 + col0;
        f32x4 gv[2][2];
#pragma unroll
        for (int bj = 0; bj < 2; ++bj)
#pragma unroll
            for (int n = 0; n < 2; ++n) gv[bj][n] = *(const f32x4*)(gate + bj * 128 + 4 * n);
#pragma unroll
        for (int ai = 0; ai < 2; ++ai) {
            u32x4 bv[4][2];
#pragma unroll
            for (int m = 0; m < 4; ++m) { const bf16_t* brow = X1 + (size_t)(row0 + ai * 128 + m * 16) * DM + col0;
#pragma unroll
                for (int bj = 0; bj < 2; ++bj) bv[m][bj] = *(const u32x4*)(brow + bj * 128); }
#pragma unroll
            for (int m = 0; m < 4; ++m) { bf16_t* orow = O + (size_t)(row0 + ai * 128 + m * 16) * DM + col0;
#pragma unroll
                for (int bj = 0; bj < 2; ++bj) { const u32x4 r = bv[m][bj];
                    const f32x4 v0 = (f32x4){bf_lo(r.x), bf_hi(r.x), bf_lo(r.y), bf_hi(r.y)} + gv[bj][0] * acc[ai][bj][m][0], v1 = (f32x4){bf_lo(r.z), bf_hi(r.z), bf_lo(r.w), bf_hi(r.w)} + gv[bj][1] * acc[ai][bj][m][1];
                    u32x4 w; w.x = cvt_pk_bf16(v0[0], v0[1]); w.y = cvt_pk_bf16(v0[2], v0[3]); w.z = cvt_pk_bf16(v1[0], v1[1]); w.w = cvt_pk_bf16(v1[2], v1[3]);
                    *(u32x4*)(orow + bj * 128) = w; } }
        }
    }
};

__device__ void transpose_tile(const float* __restrict__ src, int N, bf16_t* __restrict__ dst, int K, int k0, int n0, float* tile) {
    const int tid = threadIdx.x;
#pragma unroll
    for (int i = 0; i < 2; ++i) { const int kk = (tid >> 4) + 32 * i, n4 = (tid & 15) * 4; const f32x4 v = *(const f32x4*)(src + (size_t)(k0 + kk) * N + n0 + n4);
        tile[kk * 65 + n4] = v[0]; tile[kk * 65 + n4 + 1] = v[1]; tile[kk * 65 + n4 + 2] = v[2]; tile[kk * 65 + n4 + 3] = v[3]; }
    __syncthreads();
    { const int n = tid >> 3, k8 = (tid & 7) * 8; u32x4 w;
      w.x = cvt_pk_bf16(tile[(k8 + 0) * 65 + n], tile[(k8 + 1) * 65 + n]); w.y = cvt_pk_bf16(tile[(k8 + 2) * 65 + n], tile[(k8 + 3) * 65 + n]);
      w.z = cvt_pk_bf16(tile[(k8 + 4) * 65 + n], tile[(k8 + 5) * 65 + n]); w.w = cvt_pk_bf16(tile[(k8 + 6) * 65 + n], tile[(k8 + 7) * 65 + n]);
      *(u32x4*)(dst + (size_t)(n0 + n) * K + k0 + k8) = w; }
    __syncthreads();
}

__device__ void phase_setup(const Params& p, unsigned char* lds) {
    const int tid = threadIdx.x;
    float* sl = (float*)lds;
    float* red = (float*)(lds + 36864);
    float* modp = (float*)(p.ws + WS_MOD);
    for (int chunk = blockIdx.x; chunk < 256; chunk += gridDim.x) {
        for (int idx = tid; idx < 9216; idx += 512) { const int v = idx >> 10, k = idx & 1023; const float x = v == 0 ? p.in[5][k] : p.in[2][(v - 1) * 1024 + k]; sl[idx] = x / (1.0f + __expf(-x)); }
        __syncthreads();
        const int n0 = chunk * 24;
        if (tid < 510) {
            const int kg = tid / 6, c4 = tid % 6;
            f32x4 acc[9];
#pragma unroll
            for (int v = 0; v < 9; ++v) acc[v] = (f32x4){0.f, 0.f, 0.f, 0.f};
            for (int k = kg; k < 1024; k += 85) { const f32x4 w = *(const f32x4*)(p.in[6] + (size_t)k * 6144 + n0 + c4 * 4);
#pragma unroll
                for (int v = 0; v < 9; ++v) acc[v] += sl[v * 1024 + k] * w; }
#pragma unroll
            for (int v = 0; v < 9; ++v) *(f32x4*)(red + kg * 216 + v * 24 + c4 * 4) = acc[v];
        }
        __syncthreads();
        if (tid < 216) { float s = 0.f; for (int kg = 0; kg < 85; ++kg) s += red[kg * 216 + tid]; const int v = tid / 24, cc = tid % 24; modp[v * 6144 + n0 + cc] = s + p.in[7][n0 + cc]; }
        __syncthreads();
    }
    float* tile = (float*)lds;
    for (int t = blockIdx.x; t < 3168; t += gridDim.x) {
        if (t < 864) { const int kt = t / 54, ntl = t % 54; transpose_tile(p.in[9], ZC, (bf16_t*)(p.ws + WS_WIN), 1024, kt * 64, ntl * 64, tile); }
        else if (t < 1120) { const int u = t - 864; transpose_tile(p.in[27], 1024, (bf16_t*)(p.ws + WS_WOUT), 1024, (u >> 4) * 64, (u & 15) * 64, tile); }
        else if (t < 2144) { const int u = t - 1120; transpose_tile(p.in[29], 4096, (bf16_t*)(p.ws + WS_W1), 1024, (u >> 6) * 64, (u & 63) * 64, tile); }
        else { const int u = t - 2144; transpose_tile(p.in[30], 1024, (bf16_t*)(p.ws + WS_W2), 4096, (u >> 4) * 64, (u & 15) * 64, tile); }
    }
    const int gtid = blockIdx.x * 512 + tid, gsz = gridDim.x * 512;
    for (int i = gtid; i < 128 * 1024 / 8; i += gsz) *(u32x4*)((bf16_t*)(p.ws + WS_WIN) + (size_t)ZC * 1024 + (size_t)i * 8) = (u32x4){0u, 0u, 0u, 0u};
    bf16_t* lw = (bf16_t*)(p.ws + WS_LORA);
    for (int o = gtid; o < 4 * 32768 + 65536; o += gsz) {
        if (o < 4 * 32768) { const int mtx = o >> 15, r = o & 32767, n = r >> 6, k = r & 63; const float* src = p.in[mtx == 0 ? 12 : mtx == 1 ? 14 : mtx == 2 ? 16 : 18];
            lw[o] = (bf16_t)(cvt_pk_bf16(src[k * 512 + n], 0.f) & 0xffffu); }
        else { const int r = o - 4 * 32768, n = r >> 7, k = r & 127; lw[o] = (bf16_t)(cvt_pk_bf16(p.in[19][k * 512 + n], 0.f) & 0xffffu); }
    }
}

template <int MODE>
__device__ void phase_norm(const Params& p) {
    const int lane = threadIdx.x & 63, wid = threadIdx.x >> 6;
    const float* modp = (const float*)(p.ws + WS_MOD);
    const float* gam = MODE == 0 ? p.in[8] : MODE == 1 ? p.in[28] : p.in[31];
    bf16_t* H = (bf16_t*)(p.ws + (MODE == 1 ? WS_MIX : WS_H));
    const bf16_t* X1 = (const bf16_t*)(p.ws + WS_H);
    f32x4 g[4];
#pragma unroll
    for (int i = 0; i < 4; ++i) g[i] = *(const f32x4*)(gam + lane * 4 + 256 * i);
    for (int row0 = (blockIdx.x * 8 + wid) * 2; row0 < T_ALL; row0 += gridDim.x * 16) {
        f32x4 x[2][4], sh[2][4], sc[2][4];
#pragma unroll
        for (int u = 0; u < 2; ++u) { const int row = row0 + u; const float* src = MODE == 0 ? xrow(p, row) : p.out + (size_t)row * DM;
#pragma unroll
            for (int i = 0; i < 4; ++i) { if (MODE == 1) x[u][i] = ld_bf4(X1 + (size_t)row * DM + lane * 4 + 256 * i); else if (MODE == 2) x[u][i] = ld_bf4((const bf16_t*)(p.ws + WS_MIX) + (size_t)row * DM + lane * 4 + 256 * i); else x[u][i] = *(const f32x4*)(src + lane * 4 + 256 * i); }
            if (MODE != 2) { const float* mb = modp + mod_index(row) * 6144 + (MODE == 0 ? 0 : 3) * 1024;
#pragma unroll
                for (int i = 0; i < 4; ++i) { sh[u][i] = *(const f32x4*)(mb + lane * 4 + 256 * i); sc[u][i] = *(const f32x4*)(mb + 1024 + lane * 4 + 256 * i); } } }
#pragma unroll
        for (int u = 0; u < 2; ++u) { const int row = row0 + u; float ss = 0.f;
#pragma unroll
            for (int i = 0; i < 4; ++i) ss += x[u][i][0] * x[u][i][0] + x[u][i][1] * x[u][i][1] + x[u][i][2] * x[u][i][2] + x[u][i][3] * x[u][i][3];
            ss = wavesum(ss);
            const float rs = rsqrtf(ss * (1.0f / 1024.0f) + 1e-6f);
            if (MODE == 2) {
#pragma unroll
                for (int i = 0; i < 4; ++i) *(f32x4*)(p.out + (size_t)row * DM + lane * 4 + 256 * i) = x[u][i] * rs * g[i];
            } else {
#pragma unroll
                for (int i = 0; i < 4; ++i) { const f32x4 y = x[u][i] * rs * g[i] * (1.0f + sc[u][i]) + sh[u][i];
                    u32x2 w; w.x = cvt_pk_bf16(y[0], y[1]); w.y = cvt_pk_bf16(y[2], y[3]);
                    *(u32x2*)(H + (size_t)row * DM + lane * 4 + 256 * i) = w; }
            } }
    }
}

constexpr int XAS = 392;
template <int KL> __device__ __forceinline__ void lora_mma(f32x4 (&acc)[2], const bf16_t* XA, int m, int coff, const bf16_t* WT, int w, int n0, int fr, int fq) {
#pragma unroll
    for (int n = 0; n < 2; ++n) acc[n] = (f32x4){0.f, 0.f, 0.f, 0.f};
#pragma unroll
    for (int kk = 0; kk < KL / 32; ++kk) {
        const bf16x8 xf = *(const bf16x8*)(XA + (m * 16 + fr) * XAS + coff + kk * 32 + fq * 8);
#pragma unroll
        for (int n = 0; n < 2; ++n) { const bf16x8 wf = *(const bf16x8*)(WT + (size_t)(w * 64 + n0 * 16 + 8 * (fr >> 2) + 4 * n + (fr & 3)) * KL + kk * 32 + fq * 8);
            acc[n] = __builtin_amdgcn_mfma_f32_16x16x32_bf16(wf, xf, acc[n], 0, 0, 0); }
    }
}
template <int KL> __device__ __forceinline__ void lora_mma4(f32x4 (&acc)[4], const bf16_t* XA, int m, int coff, const bf16_t* WT, int w, int fr, int fq) {
#pragma unroll
    for (int n = 0; n < 4; ++n) acc[n] = (f32x4){0.f, 0.f, 0.f, 0.f};
#pragma unroll
    for (int kk = 0; kk < KL / 32; ++kk) {
        const bf16x8 xf = *(const bf16x8*)(XA + (m * 16 + fr) * XAS + coff + kk * 32 + fq * 8);
#pragma unroll
        for (int n = 0; n < 4; ++n) { const bf16x8 wf = *(const bf16x8*)(WT + (size_t)(w * 64 + 16 * (fr >> 2) + 4 * n + (fr & 3)) * KL + kk * 32 + fq * 8);
            acc[n] = __builtin_amdgcn_mfma_f32_16x16x32_bf16(wf, xf, acc[n], 0, 0, 0); }
    }
}
__device__ __forceinline__ void lora_loadw(bf16x8 (&wq)[8], const bf16_t* WT, int KS, int koff, int w, int fr, int fq) {
#pragma unroll
    for (int kk = 0; kk < 2; ++kk)
#pragma unroll
        for (int n = 0; n < 4; ++n) wq[kk * 4 + n] = *(const bf16x8*)(WT + (size_t)(w * 64 + 16 * (fr >> 2) + 4 * n + (fr & 3)) * KS + koff + kk * 32 + fq * 8);
}
template <bool ZERO> __device__ __forceinline__ void lora_mma4w(f32x4 (&acc)[4], const bf16_t* XA, int m, int coff, const bf16x8 (&wq)[8], int fr, int fq) {
    if (ZERO) {
#pragma unroll
        for (int n = 0; n < 4; ++n) acc[n] = (f32x4){0.f, 0.f, 0.f, 0.f}; }
#pragma unroll
    for (int kk = 0; kk < 2; ++kk) {
        const bf16x8 xf = *(const bf16x8*)(XA + (m * 16 + fr) * XAS + coff + kk * 32 + fq * 8);
#pragma unroll
        for (int n = 0; n < 4; ++n) acc[n] = __builtin_amdgcn_mfma_f32_16x16x32_bf16(wq[kk * 4 + n], xf, acc[n], 0, 0, 0);
    }
}
__device__ __forceinline__ void st_bf4(bf16_t* dst, const f32x4 v) { u32x2 w; w.x = cvt_pk_bf16(v[0], v[1]); w.y = cvt_pk_bf16(v[2], v[3]); *(u32x2*)dst = w; }

template <int SKIP> __device__ void phase_prep(const Params& p, unsigned char* lds) {
    bf16_t* XA = (bf16_t*)lds;
    const bf16_t* Z = (const bf16_t*)(p.ws + WS_Z);
    const float* mu = p.in[10];
    const bf16_t* lw = (const bf16_t*)(p.ws + WS_LORA);
    bf16_t* MIX = (bf16_t*)(p.ws + WS_MIX);
    bf16_t* Rr = (bf16_t*)((unsigned char*)p.out + OUT_R); bf16_t* Kr = (bf16_t*)((unsigned char*)p.out + OUT_K); bf16_t* Vr = (bf16_t*)((unsigned char*)p.out + OUT_V);
    bf16_t* AF = (bf16_t*)((unsigned char*)p.out + OUT_AF); bf16_t* AB = (bf16_t*)(p.ws + WS_AB); bf16_t* EF = (bf16_t*)(p.ws + WS_EF); bf16_t* EB = (bf16_t*)(p.ws + WS_EB);
    float* RN = (float*)(p.ws + WS_RN); float* SBv = (float*)(p.ws + WS_SB);
    const int tid = threadIdx.x, wid = tid >> 6, lane = tid & 63, fr = lane & 15, fq = lane >> 4;
    float* CT = (float*)(lds + 25600);
    for (int i = tid; i < 5120; i += 512) { const int a = i >> 9, c = i & 511;
        const float* src = a == 0 ? p.in[11] : a == 1 ? p.in[13] : a == 2 ? p.in[15] : a == 3 ? p.in[17] : a == 4 ? mu : a == 5 ? mu + 512 : a == 6 ? mu + 1024 : a == 7 ? p.in[20] : a == 8 ? p.in[21] : p.in[22];
        CT[i] = src[c]; }
    for (int i = tid; i < 384; i += 512) CT[5120 + i] = mu[1536 + i];
    __syncthreads();
    for (int tile = blockIdx.x; tile < T_ALL / 32; tile += gridDim.x) {
        const int t0 = tile * 32, segm = t0 < T_CTX ? 255 : 63;
#pragma unroll
        for (int i = 0; i < 3; ++i) {
            const int item = tid + 512 * i, row = item / 48, c8 = (item % 48) * 8, gt = t0 + row, pos = gt & segm;
            const int hp = pos != 0, hn = pos != segm;
            const u32x4 zc = *(const u32x4*)(Z + (size_t)gt * ZC + 1536 + c8), zp = *(const u32x4*)(Z + (size_t)(gt - hp) * ZC + 1536 + c8), zn = *(const u32x4*)(Z + (size_t)(gt + hn) * ZC + 1536 + c8);
            const f32x4 m0 = *(const f32x4*)(CT + 5120 + c8), m1 = *(const f32x4*)(CT + 5120 + c8 + 4);
            float s[8];
            const bool ident_ = c8 >= 128 && c8 < 256; const float ab_ = c8 < 128 ? 2.0f : 1.0f, cc_ = c8 < 128 ? -1.0f : 0.0f;
#pragma unroll
            for (int e = 0; e < 8; ++e) { const unsigned uc = zc[e >> 1], up = zp[e >> 1], un = zn[e >> 1];
                const float z = (e & 1) ? bf_hi(uc) : bf_lo(uc); float pv = (e & 1) ? bf_hi(up) : bf_lo(up); float nv = (e & 1) ? bf_hi(un) : bf_lo(un);
                pv = hp ? pv : 0.f; nv = hn ? nv : 0.f; const float m = e < 4 ? m0[e & 3] : m1[e & 3];
                const float v = z + m * (0.5f * (pv + nv) - z);
                const float sg_ = sigmoidf_(v * ab_);
                s[e] = ident_ ? v : sg_ * ab_ + cc_; }
            u32x4 w; w.x = cvt_pk_bf16(s[0], s[1]); w.y = cvt_pk_bf16(s[2], s[3]); w.z = cvt_pk_bf16(s[4], s[5]); w.w = cvt_pk_bf16(s[6], s[7]);
            *(u32x4*)(XA + row * XAS + c8) = w;
        }
        __syncthreads();
#pragma unroll 1
        for (int m = 0; m < ((SKIP & 1) ? 0 : 2); ++m) {
            const int w = wid, gt = t0 + m * 16 + fr, pos = gt & segm, hp = pos != 0, hn = pos != segm;
            const bf16_t* zc = Z + (size_t)gt * ZC; const bf16_t* zp = Z + (size_t)(gt - hp) * ZC; const bf16_t* zn = Z + (size_t)(gt + hn) * ZC;
            const int cb16 = w * 64 + 16 * fq;
            u32x4 zr[2][3], zk[2][3], zv[2][3];
            f32x4 acc[4], aaf[4], aab[4];
#define P3_ST16(DST, V0, V1, V2, V3) do { u32x4 w0_, w1_; w0_.x = cvt_pk_bf16((V0)[0], (V0)[1]); w0_.y = cvt_pk_bf16((V0)[2], (V0)[3]); w0_.z = cvt_pk_bf16((V1)[0], (V1)[1]); w0_.w = cvt_pk_bf16((V1)[2], (V1)[3]); \
                w1_.x = cvt_pk_bf16((V2)[0], (V2)[1]); w1_.y = cvt_pk_bf16((V2)[2], (V2)[3]); w1_.z = cvt_pk_bf16((V3)[0], (V3)[1]); w1_.w = cvt_pk_bf16((V3)[2], (V3)[3]); \
                *(u32x4*)(DST) = w0_; *(u32x4*)((DST) + 8) = w1_; } while (0)
            {
                bf16x8 w1[8], w2[8];
                lora_loadw(w1, lw, 64, 0, w, fr, fq);
                __builtin_amdgcn_sched_barrier(0);
                lora_loadw(w2, lw + 32768, 64, 0, w, fr, fq);
                lora_mma4w<true>(acc, XA, m, 0, w1, fr, fq);
                __builtin_amdgcn_sched_barrier(0);
                { f32x4 e[4];
#pragma unroll
                  for (int n = 0; n < 4; ++n) { const f32x4 b = *(const f32x4*)(CT + cb16 + 4 * n);
#pragma unroll
                      for (int j = 0; j < 4; ++j) e[n][j] = sigmoidf_(b[j] + acc[n][j]) * 0.60653066f; }
                  P3_ST16(EF + (size_t)gt * 512 + cb16, e[0], e[1], e[2], e[3]); }
                __builtin_amdgcn_sched_barrier(0);
                lora_loadw(w1, lw + 4 * 32768, 128, 0, w, fr, fq);
                lora_mma4w<true>(acc, XA, m, 64, w2, fr, fq);
                __builtin_amdgcn_sched_barrier(0);
                { f32x4 e[4];
#pragma unroll
                  for (int n = 0; n < 4; ++n) { const f32x4 b = *(const f32x4*)(CT + 512 + cb16 + 4 * n);
#pragma unroll
                      for (int j = 0; j < 4; ++j) e[n][j] = sigmoidf_(b[j] + acc[n][j]) * 0.60653066f; }
                  P3_ST16(EB + (size_t)gt * 512 + cb16, e[0], e[1], e[2], e[3]); }
                __builtin_amdgcn_sched_barrier(0);
#pragma unroll
            for (int hh = 0; hh < 2; ++hh) { const int c_ = cb16 + 8 * hh;
                zr[hh][0] = *(const u32x4*)(zc + c_); zk[hh][0] = *(const u32x4*)(zc + 512 + c_); zv[hh][0] = *(const u32x4*)(zc + 1024 + c_); }
                lora_loadw(w2, lw + 4 * 32768, 128, 64, w, fr, fq);
                lora_mma4w<true>(acc, XA, m, 256, w1, fr, fq);
                __builtin_amdgcn_sched_barrier(0);
                lora_loadw(w1, lw + 2 * 32768, 64, 0, w, fr, fq);
                lora_mma4w<false>(acc, XA, m, 256 + 64, w2, fr, fq);
                __builtin_amdgcn_sched_barrier(0);
                P3_ST16(MIX + (size_t)gt * DM + cb16, acc[0], acc[1], acc[2], acc[3]);
                __builtin_amdgcn_sched_barrier(0);
#pragma unroll
            for (int hh = 0; hh < 2; ++hh) { const int c_ = cb16 + 8 * hh;
                zr[hh][1] = *(const u32x4*)(zp + c_); zr[hh][2] = *(const u32x4*)(zn + c_); zk[hh][1] = *(const u32x4*)(zp + 512 + c_); zk[hh][2] = *(const u32x4*)(zn + 512 + c_);
                zv[hh][1] = *(const u32x4*)(zp + 1024 + c_); zv[hh][2] = *(const u32x4*)(zn + 1024 + c_); }
                lora_loadw(w2, lw + 3 * 32768, 64, 0, w, fr, fq);
                lora_mma4w<true>(aaf, XA, m, 128, w1, fr, fq);
                __builtin_amdgcn_sched_barrier(0);
                lora_mma4w<true>(aab, XA, m, 192, w2, fr, fq);
            }
            const float fp = hp ? 0.5f : 0.f, fn = hn ? 0.5f : 0.f;
            float ss = 0.f, sbp = 0.f;
#define P3_ST8(DST, V0, V1) do { u32x4 w0_; w0_.x = cvt_pk_bf16((V0)[0], (V0)[1]); w0_.y = cvt_pk_bf16((V0)[2], (V0)[3]); w0_.z = cvt_pk_bf16((V1)[0], (V1)[1]); w0_.w = cvt_pk_bf16((V1)[2], (V1)[3]); *(u32x4*)(DST) = w0_; } while (0)
#pragma unroll
            for (int hh = 0; hh < 2; ++hh) {
                f32x4 rr[2], kk2[2], vv2[2], af2[2], ab2[2];
#pragma unroll
                for (int q2 = 0; q2 < 2; ++q2) {
                    const int n = 2 * hh + q2, cb = cb16 + 4 * n;
                    const f32x4 a0f = *(const f32x4*)(CT + 1024 + cb), a0b = *(const f32x4*)(CT + 1536 + cb);
                    f32x4 af, ab;
#pragma unroll
                    for (int j = 0; j < 4; ++j) { af[j] = sigmoidf_(a0f[j] + aaf[n][j]); ab[j] = sigmoidf_(a0b[j] + aab[n][j]); }
#define UNP(U) ((f32x4){bf_lo((U)[2 * q2]), bf_hi((U)[2 * q2]), bf_lo((U)[2 * q2 + 1]), bf_hi((U)[2 * q2 + 1])})
                    f32x4 r = UNP(zr[hh][0]), k = UNP(zk[hh][0]), v = UNP(zv[hh][0]);
                    { const f32x4 mr = *(const f32x4*)(CT + 2048 + cb), mk = *(const f32x4*)(CT + 2560 + cb), mv = *(const f32x4*)(CT + 3072 + cb);
                      r += mr * (fp * UNP(zr[hh][1]) + fn * UNP(zr[hh][2]) - r);
                      k += mk * (fp * UNP(zk[hh][1]) + fn * UNP(zk[hh][2]) - k);
                      v += mv * (fp * UNP(zv[hh][1]) + fn * UNP(zv[hh][2]) - v); }
#undef UNP
                    const f32x4 kkc = *(const f32x4*)(CT + 3584 + cb), kac = *(const f32x4*)(CT + 4096 + cb), rkc = *(const f32x4*)(CT + 4608 + cb);
#pragma unroll
                    for (int j = 0; j < 4; ++j) { const float t = k[j] * kkc[j]; ss += t * t;
                        const float ksum = k[j] * (2.0f + (af[j] + ab[j] - 2.0f) * kac[j]); sbp += r[j] * ksum * rkc[j]; }
                    rr[q2] = r; kk2[q2] = k; vv2[q2] = v; af2[q2] = af; ab2[q2] = ab;
                }
                const int c_ = cb16 + 8 * hh;
                P3_ST8(AF + (size_t)gt * 512 + c_, af2[0], af2[1]); P3_ST8(AB + (size_t)gt * 512 + c_, ab2[0], ab2[1]);
                P3_ST8(Rr + (size_t)gt * 512 + c_, rr[0], rr[1]); P3_ST8(Kr + (size_t)gt * 512 + c_, kk2[0], kk2[1]); P3_ST8(Vr + (size_t)gt * 512 + c_, vv2[0], vv2[1]);
            }
#undef P3_ST8
#undef P3_ST16
            ss += __shfl_xor(ss, 16); ss += __shfl_xor(ss, 32); sbp += __shfl_xor(sbp, 16); sbp += __shfl_xor(sbp, 32);
            if (fq == 0) { RN[gt * 8 + w] = rsqrtf(ss + 1e-12f); SBv[gt * 8 + w] = sbp; }
        }
#pragma unroll 1
        for (int q2 = 0; q2 < ((SKIP & 2) ? 0 : 2); ++q2) {
            const int c8 = lane * 8;
            u32x4 gb[2], gcc[2], hcc[2], gcp[2], hcp[2], gcn[2], hcn[2]; int hpq[2], hnq[2];
#pragma unroll
            for (int u2 = 0; u2 < 2; ++u2) {
                const int gt = t0 + wid * 4 + q2 * 2 + u2, pos = gt & segm; hpq[u2] = pos != 0; hnq[u2] = pos != segm;
                const bf16_t* zc = Z + (size_t)gt * ZC + 1920 + c8; const bf16_t* zp = Z + (size_t)(gt - hpq[u2]) * ZC + 1920 + c8; const bf16_t* zn = Z + (size_t)(gt + hnq[u2]) * ZC + 1920 + c8;
                gb[u2] = *(const u32x4*)zc; gcc[u2] = *(const u32x4*)(zc + 512); hcc[u2] = *(const u32x4*)(zc + 1024); gcp[u2] = *(const u32x4*)(zp + 512); hcp[u2] = *(const u32x4*)(zp + 1024);
                gcn[u2] = *(const u32x4*)(zn + 512); hcn[u2] = *(const u32x4*)(zn + 1024);
            }
            const float* cw = p.in[25];
            const f32x4 cwa0 = *(const f32x4*)(cw + c8), cwa1 = *(const f32x4*)(cw + c8 + 4), cwb0 = *(const f32x4*)(cw + 512 + c8), cwb1 = *(const f32x4*)(cw + 512 + c8 + 4);
            const f32x4 cwc0 = *(const f32x4*)(cw + 1024 + c8), cwc1 = *(const f32x4*)(cw + 1024 + c8 + 4), cg0 = *(const f32x4*)(p.in[26] + c8), cg1 = *(const f32x4*)(p.in[26] + c8 + 4);
#pragma unroll
            for (int u2 = 0; u2 < 2; ++u2) {
                const int gt = t0 + wid * 4 + q2 * 2 + u2;
                float o[8], ss = 0.f;
#pragma unroll
                for (int e = 0; e < 8; ++e) {
                    const int h2 = e >> 1;
#define BFSEL(U) ((e & 1) ? bf_hi(U[u2][h2]) : bf_lo(U[u2][h2]))
                    const float u = BFSEL(gcc) * BFSEL(hcc), up = hpq[u2] ? BFSEL(gcp) * BFSEL(hcp) : 0.f, un = hnq[u2] ? BFSEL(gcn) * BFSEL(hcn) : 0.f;
                    const float w0 = e < 4 ? cwa0[e & 3] : cwa1[e & 3], w1 = e < 4 ? cwb0[e & 3] : cwb1[e & 3], w2 = e < 4 ? cwc0[e & 3] : cwc1[e & 3];
                    o[e] = BFSEL(gb) * (w0 * up + w1 * u + w2 * un); ss += o[e] * o[e];
#undef BFSEL
                }
                ss = wavesum(ss);
                const float rs = rsqrtf(ss * (1.0f / 512.0f) + 1e-6f);
                u32x4 wv; wv.x = cvt_pk_bf16(o[0] * rs * cg0[0], o[1] * rs * cg0[1]); wv.y = cvt_pk_bf16(o[2] * rs * cg0[2], o[3] * rs * cg0[3]);
                wv.z = cvt_pk_bf16(o[4] * rs * cg1[0], o[5] * rs * cg1[1]); wv.w = cvt_pk_bf16(o[6] * rs * cg1[2], o[7] * rs * cg1[3]);
                *(u32x4*)(MIX + (size_t)gt * DM + 512 + c8) = wv;
            }
        }
        __syncthreads();
    }
}

struct ScanDesc { int base, L, h, hf, dir, b; };
__device__ __forceinline__ ScanDesc scan_decode(bool lat, int uu) {
    ScanDesc d; const int s = uu >> 1; d.hf = uu & 1; d.b = s >> 4; d.h = (s >> 1) & 7; d.dir = s & 1;
    d.L = lat ? 4096 : 256; d.base = lat ? T_CTX + d.b * 4096 : d.b * 256; return d;
}
__device__ __forceinline__ float rowsum8(float x) { x += dpp_<0xB1>(x); x += dpp_<0x4E>(x); x += dpp_<0x141>(x); return x; }
__device__ void phase_scan(const Params& p, unsigned char* lds) {
    constexpr int TC = 16, BUF = 5 * TC * 64 + TC * 32;
    const int tid = threadIdx.x, hb = __builtin_amdgcn_readfirstlane(tid >> 8), lt = tid & 255;
    float* bufs0 = (float*)lds;
    float* bufs = bufs0 + hb * (2 * BUF);
    float* EB = bufs0 + 4 * BUF + 2 * TC * 256;
    float* YP = bufs0 + 4 * BUF;
    const bf16_t* Rr = (const bf16_t*)((unsigned char*)p.out + OUT_R); const bf16_t* Kr = (const bf16_t*)((unsigned char*)p.out + OUT_K); const bf16_t* Vr = (const bf16_t*)((unsigned char*)p.out + OUT_V);
    const float* RN = (const float*)(p.ws + WS_RN);
    const bool lat = hb == 0;
    const int rl = lt >> 3, jo = lt & 7, j8 = jo * 8;
    const int sst = lt >> 4, sj4 = (lt & 15) * 4;
    const int vst = (lt & 127) >> 3, vi4 = (lt & 7) * 4;
    const int ncu_sh = lat ? 8 : 4;
    const int G = gridDim.x, bid = blockIdx.x;
    const int n0 = bid < 256 ? (256 - bid + G - 1) / G : 0, n1 = bid < 1024 ? (1024 - bid + G - 1) / G : 0;
    const int myslots = lat ? (n0 << 8) : (n1 << 4), maxslots = (n0 << 8) > (n1 << 4) ? (n0 << 8) : (n1 << 4);
    const int X = n1 << 4;
    const bool handoff = (n0 == 1) && (n1 == 4);
    const int endA = handoff ? X : maxslots;
    constexpr int RD = 4;
    const int lastslot = myslots > 0 ? myslots - 1 : 0;
    u32x2 pr[RD], pk[RD], pa[RD], pe[RD], pv[RD]; float prn[RD]; f32x4 nkkc[RD], nkac[RD];
#define SC_TOK(d, step) ((d).dir ? (d).base + (d).L - 1 - (step) : (d).base + (step))
#define SC_LOADX(q, slot, LATF, NSH) do { const ScanDesc d_ = scan_decode(LATF, bid + ((slot) >> (NSH)) * G); const int c_ = (slot) & ((1 << (NSH)) - 1); \
        const int t_ = SC_TOK(d_, c_ * TC + sst); const size_t o_ = (size_t)t_ * 512 + d_.h * 64 + sj4; \
        const bf16_t* Ar_ = d_.dir ? (const bf16_t*)(p.ws + WS_AB) : (const bf16_t*)((unsigned char*)p.out + OUT_AF); \
        const bf16_t* Er_ = d_.dir ? (const bf16_t*)(p.ws + WS_EB) : (const bf16_t*)(p.ws + WS_EF); \
        pr[q] = *(const u32x2*)(Rr + o_); pk[q] = *(const u32x2*)(Kr + o_); pa[q] = *(const u32x2*)(Ar_ + o_); pe[q] = *(const u32x2*)(Er_ + o_); prn[q] = RN[t_ * 8 + d_.h]; \
        nkkc[q] = *(const f32x4*)(p.in[20] + d_.h * 64 + sj4); nkac[q] = *(const f32x4*)(p.in[21] + d_.h * 64 + sj4); \
        { const int t2_ = SC_TOK(d_, c_ * TC + vst); pv[q] = *(const u32x2*)(Vr + (size_t)t2_ * 512 + d_.h * 64 + d_.hf * 32 + vi4); } } while (0)
#define SC_CONVX(q, bi, BUFS) do { float* B_ = (BUFS) + (bi) * BUF; \
        const f32x4 r_ = (f32x4){bf_lo(pr[q].x), bf_hi(pr[q].x), bf_lo(pr[q].y), bf_hi(pr[q].y)}, k_ = (f32x4){bf_lo(pk[q].x), bf_hi(pk[q].x), bf_lo(pk[q].y), bf_hi(pk[q].y)}; \
        const f32x4 a_ = (f32x4){bf_lo(pa[q].x), bf_hi(pa[q].x), bf_lo(pa[q].y), bf_hi(pa[q].y)}, e_ = (f32x4){bf_lo(pe[q].x), bf_hi(pe[q].x), bf_lo(pe[q].y), bf_hi(pe[q].y)}; \
        f32x4 w_; w_[0] = __expf(-e_[0]); w_[1] = __expf(-e_[1]); w_[2] = __expf(-e_[2]); w_[3] = __expf(-e_[3]); \
        const f32x4 kk_ = k_ * nkkc[q] * prn[q], kd_ = k_ * (1.0f + (a_ - 1.0f) * nkac[q]), ka_ = kk_ * a_; \
        *(f32x4*)(B_ + 0 * TC * 64 + sst * 64 + sj4) = w_; *(f32x4*)(B_ + 1 * TC * 64 + sst * 64 + sj4) = kd_; *(f32x4*)(B_ + 2 * TC * 64 + sst * 64 + sj4) = ka_; \
        *(f32x4*)(B_ + 3 * TC * 64 + sst * 64 + sj4) = kk_; *(f32x4*)(B_ + 4 * TC * 64 + sst * 64 + sj4) = r_; \
        if (lt < 128) *(f32x4*)(B_ + 5 * TC * 64 + vst * 32 + vi4) = (f32x4){bf_lo(pv[q].x), bf_hi(pv[q].x), bf_lo(pv[q].y), bf_hi(pv[q].y)}; } while (0)
#define SC_LOAD(q, slot) SC_LOADX(q, slot, lat, ncu_sh)
#define SC_CONV(q, bi) SC_CONVX(q, bi, bufs)
#define SC_RD(st, w0_, w1_, k0_, k1_, a0_, a1_, q0_, q1_, r0_, r1_, v_) do { const float* b_ = B + (st) * 64; \
            w0_ = *(const f32x4*)(b_); w1_ = *(const f32x4*)(b_ + 4); k0_ = *(const f32x4*)(b_ + TC * 64); k1_ = *(const f32x4*)(b_ + TC * 64 + 4); \
            a0_ = *(const f32x4*)(b_ + 2 * TC * 64); a1_ = *(const f32x4*)(b_ + 2 * TC * 64 + 4); q0_ = *(const f32x4*)(b_ + 3 * TC * 64); q1_ = *(const f32x4*)(b_ + 3 * TC * 64 + 4); \
            r0_ = *(const f32x4*)(b_ + 4 * TC * 64); r1_ = *(const f32x4*)(b_ + 4 * TC * 64 + 4); v_ = Bv[(st) * 32]; } while (0)
#define SC_COMPUTE(s, LATF, NSH, BUFS, YMODE) do { \
            const int k = (s) >> (NSH), c = (s) & ((1 << (NSH)) - 1); \
            const ScanDesc d = scan_decode(LATF, bid + k * G); \
            const int i = d.hf * 32 + rl; \
            if (c == 0) { \
                if (LATF) { const float* sp = p.in[d.dir ? 4 : 3] + ((size_t)(d.b * 8 + d.h) * 64 + i) * 64 + j8; const f32x4 a = *(const f32x4*)sp, b2 = *(const f32x4*)(sp + 4); \
                    S0 = (f32x2){a[0], a[1]}; S1 = (f32x2){a[2], a[3]}; S2 = (f32x2){b2[0], b2[1]}; S3 = (f32x2){b2[2], b2[3]}; } \
                else { S0 = (f32x2){0.f, 0.f}; S1 = S0; S2 = S0; S3 = S0; } \
            } \
            const float* B = (BUFS) + ((s) & 1) * BUF + j8; \
            const float* Bv = (BUFS) + ((s) & 1) * BUF + 5 * TC * 64 + rl; \
            float yk0 = 0.f, yk1 = 0.f; \
            f32x4 cw0, cw1, ck0, ck1, ca0, ca1, cq0, cq1, cr0, cr1; float cv; \
            SC_RD(0, cw0, cw1, ck0, ck1, ca0, ca1, cq0, cq1, cr0, cr1, cv); \
            _Pragma("unroll") \
            for (int st = 0; st < TC; ++st) { \
                f32x4 nw0, nw1, nk0, nk1, na0, na1, nq0, nq1, nr0, nr1; float nv; \
                if (st + 1 < TC) SC_RD(st + 1, nw0, nw1, nk0, nk1, na0, na1, nq0, nq1, nr0, nr1, nv); \
                f32x2 pq = S0 * (f32x2){cq0[0], cq0[1]}; pq += S1 * (f32x2){cq0[2], cq0[3]}; pq += S2 * (f32x2){cq1[0], cq1[1]}; pq += S3 * (f32x2){cq1[2], cq1[3]}; \
                const f32x2 vv = {cv, cv}; \
                f32x2 t0 = S0 * (f32x2){cw0[0], cw0[1]} + vv * (f32x2){ck0[0], ck0[1]}, t1 = S1 * (f32x2){cw0[2], cw0[3]} + vv * (f32x2){ck0[2], ck0[3]}; \
                f32x2 t2 = S2 * (f32x2){cw1[0], cw1[1]} + vv * (f32x2){ck1[0], ck1[1]}, t3 = S3 * (f32x2){cw1[2], cw1[3]} + vv * (f32x2){ck1[2], ck1[3]}; \
                const float sa = rowsum8(pq[0] + pq[1]); \
                const f32x2 nsa = {-sa, -sa}; \
                S0 = t0 + nsa * (f32x2){ca0[0], ca0[1]}; S1 = t1 + nsa * (f32x2){ca0[2], ca0[3]}; S2 = t2 + nsa * (f32x2){ca1[0], ca1[1]}; S3 = t3 + nsa * (f32x2){ca1[2], ca1[3]}; \
                f32x2 py = S0 * (f32x2){cr0[0], cr0[1]}; py += S1 * (f32x2){cr0[2], cr0[3]}; py += S2 * (f32x2){cr1[0], cr1[1]}; py += S3 * (f32x2){cr1[2], cr1[3]}; \
                if (YMODE) YP[((s) & 1) * (TC * 256) + st * 256 + lt] = py[0] + py[1];        \
                else { const float y = rowsum8(py[0] + py[1]); \
                       if (st < 8) yk0 = (jo == (st & 7)) ? y : yk0; else yk1 = (jo == (st & 7)) ? y : yk1; } \
                if (st + 1 < TC) { cw0 = nw0; cw1 = nw1; ck0 = nk0; ck1 = nk1; ca0 = na0; ca1 = na1; cq0 = nq0; cq1 = nq1; cr0 = nr0; cr1 = nr1; cv = nv; } \
            } \
            if (!(YMODE)) { bf16_t* Yg = (bf16_t*)(p.ws + (d.dir ? WS_YB : WS_YF)); const int ta = SC_TOK(d, c * TC + jo), tb = SC_TOK(d, c * TC + 8 + jo); \
              Yg[(size_t)ta * 512 + d.h * 64 + i] = f2bf(yk0); Yg[(size_t)tb * 512 + d.h * 64 + i] = f2bf(yk1); } \
            if (!(LATF) && c == (1 << (NSH)) - 1) { float* sp = p.out + (d.dir ? OUT_SB : OUT_SF) + ((size_t)(d.b * 8 + d.h) * 64 + i) * 64 + j8; \
                *(f32x4*)sp = (f32x4){S0[0], S0[1], S1[0], S1[1]}; *(f32x4*)(sp + 4) = (f32x4){S2[0], S2[1], S3[0], S3[1]}; } \
        } while (0)
#define SC_COMPUTE_F(s) do { \
            const float* B = bufs0 + ((s) & 1) * BUF + j8; \
            const float* Bv = bufs0 + ((s) & 1) * BUF + 5 * TC * 64 + rl; \
            f32x4 ck0, ck1, ca0, ca1, cq0, cq1, cr0, cr1; float cv; \
            { const float* b_ = B; ck0 = *(const f32x4*)(b_ + TC * 64); ck1 = *(const f32x4*)(b_ + TC * 64 + 4); ca0 = *(const f32x4*)(b_ + 2 * TC * 64); ca1 = *(const f32x4*)(b_ + 2 * TC * 64 + 4); \
              cq0 = *(const f32x4*)(b_ + 3 * TC * 64); cq1 = *(const f32x4*)(b_ + 3 * TC * 64 + 4); cr0 = *(const f32x4*)(b_ + 4 * TC * 64); cr1 = *(const f32x4*)(b_ + 4 * TC * 64 + 4); cv = Bv[0]; } \
            _Pragma("unroll") \
            for (int st = 0; st < TC; ++st) { \
                f32x4 nk0, nk1, na0, na1, nq0, nq1, nr0, nr1; float nv; \
                if (st + 1 < TC) { const float* b_ = B + (st + 1) * 64; nk0 = *(const f32x4*)(b_ + TC * 64); nk1 = *(const f32x4*)(b_ + TC * 64 + 4); na0 = *(const f32x4*)(b_ + 2 * TC * 64); na1 = *(const f32x4*)(b_ + 2 * TC * 64 + 4); \
                    nq0 = *(const f32x4*)(b_ + 3 * TC * 64); nq1 = *(const f32x4*)(b_ + 3 * TC * 64 + 4); nr0 = *(const f32x4*)(b_ + 4 * TC * 64); nr1 = *(const f32x4*)(b_ + 4 * TC * 64 + 4); nv = Bv[(st + 1) * 32]; } \
                f32x2 pq = S0 * (f32x2){cq0[0], cq0[1]}; pq += S1 * (f32x2){cq0[2], cq0[3]}; pq += S2 * (f32x2){cq1[0], cq1[1]}; pq += S3 * (f32x2){cq1[2], cq1[3]}; \
                const f32x2 vv = {cv, cv}; \
                const f32x2 t0 = S0 + vv * (f32x2){ck0[0], ck0[1]}, t1 = S1 + vv * (f32x2){ck0[2], ck0[3]}, t2 = S2 + vv * (f32x2){ck1[0], ck1[1]}, t3 = S3 + vv * (f32x2){ck1[2], ck1[3]}; \
                const float sa = rowsum8(pq[0] + pq[1]); \
                const f32x2 nsa = {-sa, -sa}; \
                S0 = t0 + nsa * (f32x2){ca0[0], ca0[1]}; S1 = t1 + nsa * (f32x2){ca0[2], ca0[3]}; S2 = t2 + nsa * (f32x2){ca1[0], ca1[1]}; S3 = t3 + nsa * (f32x2){ca1[2], ca1[3]}; \
                f32x2 py = S0 * (f32x2){cr0[0], cr0[1]}; py += S1 * (f32x2){cr0[2], cr0[3]}; py += S2 * (f32x2){cr1[0], cr1[1]}; py += S3 * (f32x2){cr1[2], cr1[3]}; \
                YP[((s) & 1) * (TC * 256) + st * 256 + lt] = py[0] + py[1]; \
                if (st + 1 < TC) { ck0 = nk0; ck1 = nk1; ca0 = na0; ca1 = na1; cq0 = nq0; cq1 = nq1; cr0 = nr0; cr1 = nr1; cv = nv; } \
            } \
            { const f32x4 e0 = *(const f32x4*)(B), e1 = *(const f32x4*)(B + 4); \
              S0 *= (f32x2){e0[0], e0[1]}; S1 *= (f32x2){e0[2], e0[3]}; S2 *= (f32x2){e1[0], e1[1]}; S3 *= (f32x2){e1[2], e1[3]}; } \
        } while (0)
#define SC_UNPE(q) ((f32x4){bf_lo(pe[q].x), bf_hi(pe[q].x), bf_lo(pe[q].y), bf_hi(pe[q].y)})
#define SC_EWR(q, bi) do { f32x4 x_ = SC_UNPE(q); const int i4_ = sst & 3; \
        _Pragma("unroll") for (int j_ = 0; j_ < 4; ++j_) { const float y_ = __shfl_up(x_[j_], 16); x_[j_] += i4_ >= 1 ? y_ : 0.f; } \
        _Pragma("unroll") for (int j_ = 0; j_ < 4; ++j_) { const float y_ = __shfl_up(x_[j_], 32); x_[j_] += i4_ >= 2 ? y_ : 0.f; } \
        pin_ = x_; if (i4_ == 3) *(f32x4*)(EB + (bi) * 256 + (sst >> 2) * 64 + sj4) = x_; } while (0)
#define SC_CONVF(q, bi) do { float* B_ = bufs0 + (bi) * BUF; const float* G_ = EB + (bi) * 256 + sj4; const int w_ = sst >> 2; \
        const f32x4 r_ = (f32x4){bf_lo(pr[q].x), bf_hi(pr[q].x), bf_lo(pr[q].y), bf_hi(pr[q].y)}, k_ = (f32x4){bf_lo(pk[q].x), bf_hi(pk[q].x), bf_lo(pk[q].y), bf_hi(pk[q].y)}; \
        const f32x4 a_ = (f32x4){bf_lo(pa[q].x), bf_hi(pa[q].x), bf_lo(pa[q].y), bf_hi(pa[q].y)}, e_ = SC_UNPE(q); \
        f32x4 cum_ = pin_; \
        _Pragma("unroll") for (int g_ = 0; g_ < 3; ++g_) { const f32x4 gv_ = *(const f32x4*)(G_ + g_ * 64); const float m_ = g_ < w_ ? 1.0f : 0.0f; cum_ += gv_ * m_; } \
        const f32x4 cpr_ = cum_ - e_; \
        f32x4 pt_, pm_, ip_; \
        _Pragma("unroll") for (int j_ = 0; j_ < 4; ++j_) { pt_[j_] = __expf(-cum_[j_]); pm_[j_] = __expf(-cpr_[j_]); ip_[j_] = __expf(cum_[j_]); } \
        const f32x4 kk_ = k_ * lkkL_ * prn[q], kd_ = k_ * (1.0f + (a_ - 1.0f) * lkaL_), ka_ = kk_ * a_; \
        if (sst == TC - 1) *(f32x4*)(B_ + sj4) = pt_; \
        *(f32x4*)(B_ + 1 * TC * 64 + sst * 64 + sj4) = kd_ * ip_; *(f32x4*)(B_ + 2 * TC * 64 + sst * 64 + sj4) = ka_ * ip_; \
        *(f32x4*)(B_ + 3 * TC * 64 + sst * 64 + sj4) = kk_ * pm_; *(f32x4*)(B_ + 4 * TC * 64 + sst * 64 + sj4) = r_ * pt_; \
        if (lt < 128) *(f32x4*)(B_ + 5 * TC * 64 + vst * 32 + vi4) = (f32x4){bf_lo(pv[q].x), bf_hi(pv[q].x), bf_lo(pv[q].y), bf_hi(pv[q].y)}; } while (0)
    f32x2 S0 = {0.f, 0.f}, S1 = {0.f, 0.f}, S2 = {0.f, 0.f}, S3 = {0.f, 0.f};
    if (!handoff) {
#pragma unroll
        for (int q = 0; q < RD; ++q) SC_LOAD(q, (q < myslots ? q : lastslot));
        SC_CONV(0, 0);
        __syncthreads();
        for (int s0 = 0; s0 < maxslots; s0 += RD) {
#pragma unroll
          for (int q = 0; q < RD; ++q) {
            const int s = s0 + q;
            { const int ls = s + RD < myslots ? s + RD : lastslot; SC_LOAD(q, ls); }
            if (s < myslots) SC_COMPUTE(s, lat, ncu_sh, bufs, 0);
            if (s + 1 < myslots) SC_CONV((q + 1) % RD, (s + 1) & 1);
            __syncthreads();
          }
        }
    } else {
        const ScanDesc d0 = scan_decode(true, bid);
        if (hb == 0) {
            { const int i = d0.hf * 32 + rl; const float* sp = p.in[d0.dir ? 4 : 3] + ((size_t)(d0.b * 8 + d0.h) * 64 + i) * 64 + j8; const f32x4 a = *(const f32x4*)sp, b2 = *(const f32x4*)(sp + 4);
              S0 = (f32x2){a[0], a[1]}; S1 = (f32x2){a[2], a[3]}; S2 = (f32x2){b2[0], b2[1]}; S3 = (f32x2){b2[2], b2[3]}; }
            __syncthreads(); __syncthreads();
#pragma unroll 1
            for (int s = 0; s < maxslots; ++s) { SC_COMPUTE_F(s); __syncthreads(); }
        } else {
            const f32x4 lkkL_ = *(const f32x4*)(p.in[20] + d0.h * 64 + sj4), lkaL_ = *(const f32x4*)(p.in[21] + d0.h * 64 + sj4);
            const int sgn = d0.dir ? -1 : 1, cstep = sgn * 16 * 512;
            const int t0_ = d0.dir ? d0.base + d0.L - 1 - sst : d0.base + sst, tv0_ = d0.dir ? d0.base + d0.L - 1 - vst : d0.base + vst;
            const size_t o0_ = (size_t)t0_ * 512 + d0.h * 64 + sj4;
            const bf16_t* pR0 = Rr + o0_; const bf16_t* pK0 = Kr + o0_;
            const bf16_t* pA0 = (d0.dir ? (const bf16_t*)(p.ws + WS_AB) : (const bf16_t*)((unsigned char*)p.out + OUT_AF)) + o0_;
            const bf16_t* pE0 = (d0.dir ? (const bf16_t*)(p.ws + WS_EB) : (const bf16_t*)(p.ws + WS_EF)) + o0_;
            const float* pN0 = RN + t0_ * 8 + d0.h;
            const bf16_t* pV0 = Vr + (size_t)tv0_ * 512 + d0.h * 64 + d0.hf * 32 + vi4;
#define SC_LOADL(q, c) do { const long off_ = (long)(c) * cstep; \
                pr[q] = *(const u32x2*)(pR0 + off_); pk[q] = *(const u32x2*)(pK0 + off_); pa[q] = *(const u32x2*)(pA0 + off_); pe[q] = *(const u32x2*)(pE0 + off_); \
                prn[q] = pN0[(c) * (sgn * 128)]; pv[q] = *(const u32x2*)(pV0 + off_); } while (0)
            bf16_t* Yp0[2];
#pragma unroll
            for (int e2 = 0; e2 < 2; ++e2) { const int st_ = (lt + 256 * e2) >> 5; const int ty_ = d0.dir ? d0.base + d0.L - 1 - st_ : d0.base + st_;
                Yp0[e2] = (bf16_t*)(p.ws + (d0.dir ? WS_YB : WS_YF)) + (size_t)ty_ * 512 + d0.h * 64 + d0.hf * 32 + (lt & 31); }
#define SC_YRED(cs) do { const float* yp_ = YP + ((cs) & 1) * (TC * 256); \
                _Pragma("unroll") for (int e2 = 0; e2 < 2; ++e2) { const int e_ = lt + 256 * e2; \
                    const f32x4 u0 = *(const f32x4*)(yp_ + e_ * 8), u1 = *(const f32x4*)(yp_ + e_ * 8 + 4); \
                    Yp0[e2][(long)(cs) * cstep] = f2bf(((u0[0] + u0[1]) + (u0[2] + u0[3])) + ((u1[0] + u1[1]) + (u1[2] + u1[3]))); } } while (0)
            u32x2 c_r[2], c_k[2], c_a[2], c_e[2], c_v[2]; float c_n[2]; int c_h[2];
#define SC_CLOAD(ci, cs) do { const ScanDesc d_ = scan_decode(false, bid + ((cs) >> 4) * G); const int c_ = (cs) & 15; \
                const int t_ = SC_TOK(d_, c_ * TC + sst); const size_t o_ = (size_t)t_ * 512 + d_.h * 64 + sj4; \
                const bf16_t* Ar_ = d_.dir ? (const bf16_t*)(p.ws + WS_AB) : (const bf16_t*)((unsigned char*)p.out + OUT_AF); \
                const bf16_t* Er_ = d_.dir ? (const bf16_t*)(p.ws + WS_EB) : (const bf16_t*)(p.ws + WS_EF); \
                c_r[ci] = *(const u32x2*)(Rr + o_); c_k[ci] = *(const u32x2*)(Kr + o_); c_a[ci] = *(const u32x2*)(Ar_ + o_); c_e[ci] = *(const u32x2*)(Er_ + o_); c_n[ci] = RN[t_ * 8 + d_.h]; \
                c_h[ci] = d_.h; \
                { const int t2_ = SC_TOK(d_, c_ * TC + vst); c_v[ci] = *(const u32x2*)(Vr + (size_t)t2_ * 512 + d_.h * 64 + d_.hf * 32 + vi4); } } while (0)
#define SC_CCONV(ci, bi) do { float* B_ = bufs + (bi) * BUF; const f32x4 ckk_ = *(const f32x4*)(p.in[20] + c_h[ci] * 64 + sj4), cka_ = *(const f32x4*)(p.in[21] + c_h[ci] * 64 + sj4); \
                const f32x4 r_ = (f32x4){bf_lo(c_r[ci].x), bf_hi(c_r[ci].x), bf_lo(c_r[ci].y), bf_hi(c_r[ci].y)}, k_ = (f32x4){bf_lo(c_k[ci].x), bf_hi(c_k[ci].x), bf_lo(c_k[ci].y), bf_hi(c_k[ci].y)}; \
                const f32x4 a_ = (f32x4){bf_lo(c_a[ci].x), bf_hi(c_a[ci].x), bf_lo(c_a[ci].y), bf_hi(c_a[ci].y)}, e_ = (f32x4){bf_lo(c_e[ci].x), bf_hi(c_e[ci].x), bf_lo(c_e[ci].y), bf_hi(c_e[ci].y)}; \
                f32x4 w_; w_[0] = __expf(-e_[0]); w_[1] = __expf(-e_[1]); w_[2] = __expf(-e_[2]); w_[3] = __expf(-e_[3]); \
                const f32x4 kk_ = k_ * ckk_ * c_n[ci], kd_ = k_ * (1.0f + (a_ - 1.0f) * cka_), ka_ = kk_ * a_; \
                *(f32x4*)(B_ + 0 * TC * 64 + sst * 64 + sj4) = w_; *(f32x4*)(B_ + 1 * TC * 64 + sst * 64 + sj4) = kd_; *(f32x4*)(B_ + 2 * TC * 64 + sst * 64 + sj4) = ka_; \
                *(f32x4*)(B_ + 3 * TC * 64 + sst * 64 + sj4) = kk_; *(f32x4*)(B_ + 4 * TC * 64 + sst * 64 + sj4) = r_; \
                if (lt < 128) *(f32x4*)(B_ + 5 * TC * 64 + vst * 32 + vi4) = (f32x4){bf_lo(c_v[ci].x), bf_hi(c_v[ci].x), bf_lo(c_v[ci].y), bf_hi(c_v[ci].y)}; } while (0)
            float ykc0 = 0.f, ykc1 = 0.f;
#define SC_CQ(cs, QQ, CPAR) do { \
                const int c = (cs) & 15; const ScanDesc d = scan_decode(false, bid + ((cs) >> 4) * G); const int i = d.hf * 32 + rl; \
                if ((QQ) == 0) { ykc0 = 0.f; ykc1 = 0.f; if (c == 0) { S0 = (f32x2){0.f, 0.f}; S1 = S0; S2 = S0; S3 = S0; } } \
                const float* B = bufs + (CPAR) * BUF + j8 + (QQ) * 4 * 64; const float* Bv = bufs + (CPAR) * BUF + 5 * TC * 64 + rl + (QQ) * 4 * 32; \
                f32x4 cw0, cw1, ck0, ck1, ca0, ca1, cq0, cq1, cr0, cr1; float cv; \
                _Pragma("unroll") \
                for (int i4 = 0; i4 < 4; ++i4) { const int st = (QQ) * 4 + i4; \
                    SC_RD(i4, cw0, cw1, ck0, ck1, ca0, ca1, cq0, cq1, cr0, cr1, cv); \
                    f32x2 pq = S0 * (f32x2){cq0[0], cq0[1]}; pq += S1 * (f32x2){cq0[2], cq0[3]}; pq += S2 * (f32x2){cq1[0], cq1[1]}; pq += S3 * (f32x2){cq1[2], cq1[3]}; \
                    const f32x2 vv = {cv, cv}; \
                    f32x2 t0 = S0 * (f32x2){cw0[0], cw0[1]} + vv * (f32x2){ck0[0], ck0[1]}, t1 = S1 * (f32x2){cw0[2], cw0[3]} + vv * (f32x2){ck0[2], ck0[3]}; \
                    f32x2 t2 = S2 * (f32x2){cw1[0], cw1[1]} + vv * (f32x2){ck1[0], ck1[1]}, t3 = S3 * (f32x2){cw1[2], cw1[3]} + vv * (f32x2){ck1[2], ck1[3]}; \
                    const float sa = rowsum8(pq[0] + pq[1]); \
                    const f32x2 nsa = {-sa, -sa}; \
                    S0 = t0 + nsa * (f32x2){ca0[0], ca0[1]}; S1 = t1 + nsa * (f32x2){ca0[2], ca0[3]}; S2 = t2 + nsa * (f32x2){ca1[0], ca1[1]}; S3 = t3 + nsa * (f32x2){ca1[2], ca1[3]}; \
                    f32x2 py = S0 * (f32x2){cr0[0], cr0[1]}; py += S1 * (f32x2){cr0[2], cr0[3]}; py += S2 * (f32x2){cr1[0], cr1[1]}; py += S3 * (f32x2){cr1[2], cr1[3]}; \
                    const float y = rowsum8(py[0] + py[1]); \
                    if (st < 8) ykc0 = (jo == (st & 7)) ? y : ykc0; else ykc1 = (jo == (st & 7)) ? y : ykc1; \
                } \
                if ((QQ) == 3) { bf16_t* Yg = (bf16_t*)(p.ws + (d.dir ? WS_YB : WS_YF)); const int ta = SC_TOK(d, c * TC + jo), tb = SC_TOK(d, c * TC + 8 + jo); \
                    Yg[(size_t)ta * 512 + d.h * 64 + i] = f2bf(ykc0); Yg[(size_t)tb * 512 + d.h * 64 + i] = f2bf(ykc1); \
                    if (c == 15) { float* sp = p.out + (d.dir ? OUT_SB : OUT_SF) + ((size_t)(d.b * 8 + d.h) * 64 + i) * 64 + j8; \
                        *(f32x4*)sp = (f32x4){S0[0], S0[1], S1[0], S1[1]}; *(f32x4*)(sp + 4) = (f32x4){S2[0], S2[1], S3[0], S3[1]}; } } \
            } while (0)
            f32x4 pin_ = (f32x4){0.f, 0.f, 0.f, 0.f};
#pragma unroll
            for (int q = 0; q < RD; ++q) SC_LOADL(q, q);
            SC_CLOAD(0, 0); SC_CLOAD(1, 1);
            SC_EWR(0, 0);
            SC_CCONV(0, 0);
            __syncthreads();
            SC_CONVF(0, 0);
            SC_LOADL(0, 4);
            SC_EWR(1, 1);
            __syncthreads();
            for (int s0 = 0; s0 < maxslots; s0 += 8) {
#pragma unroll
              for (int h8 = 0; h8 < 8; ++h8) {
                const int s = s0 + h8, cs = s >> 2;
                if (s > 0) SC_YRED(s - 1);
                if (s + 1 < maxslots) SC_CONVF((h8 + 1) & 3, (h8 + 1) & 1);
                SC_EWR((h8 + 2) & 3, h8 & 1);
                { const int ls = s + 5 < maxslots ? s + 5 : maxslots - 1; SC_LOADL((h8 + 1) & 3, ls); }
                SC_CQ(cs, h8 & 3, h8 >> 2);
                if ((h8 & 3) == 0) { const int lc = cs + 2 < 64 ? cs + 2 : 63; SC_CLOAD(h8 >> 2, lc); }
                if ((h8 & 3) == 2) { if (cs + 1 < 64) SC_CCONV((h8 >> 2) ^ 1, (h8 >> 2) ^ 1); }
                __syncthreads();
              }
            }
            SC_YRED(maxslots - 1);
#undef SC_LOADL
#undef SC_YRED
#undef SC_CLOAD
#undef SC_CCONV
#undef SC_CQ
        }
    }
#undef SC_EWR
#undef SC_CONVF
#undef SC_UNPE
#undef SC_COMPUTE_F
#undef SC_TOK
#undef SC_LOADX
#undef SC_CONVX
#undef SC_LOAD
#undef SC_CONV
#undef SC_RD
#undef SC_COMPUTE
}

__device__ void phase_combine(const Params& p) {
    const bf16_t* YF = (const bf16_t*)(p.ws + WS_YF); const bf16_t* YB = (const bf16_t*)(p.ws + WS_YB);
    const bf16_t* Vr = (const bf16_t*)((unsigned char*)p.out + OUT_V); bf16_t* MIX = (bf16_t*)(p.ws + WS_MIX); const float* SBv = (const float*)(p.ws + WS_SB);
    for (int item0 = blockIdx.x * 512 + threadIdx.x; item0 < T_ALL * 128; item0 += gridDim.x * 1024) {
        f32x4 yv[2], lw[2], lb[2], vv[2], gv[2]; float sb[2];
#pragma unroll
        for (int u = 0; u < 2; ++u) { const int item = item0 + u * gridDim.x * 512, t = item >> 7, c = (item & 127) * 4, h = c >> 6;
            yv[u] = ld_bf4(YF + (size_t)t * 512 + c) + ld_bf4(YB + (size_t)t * 512 + c);
            lw[u] = *(const f32x4*)(p.in[23] + c); lb[u] = *(const f32x4*)(p.in[24] + c);
            vv[u] = ld_bf4(Vr + (size_t)t * 512 + c); gv[u] = ld_bf4(MIX + (size_t)t * DM + c); sb[u] = SBv[t * 8 + h]; }
#pragma unroll
        for (int u = 0; u < 2; ++u) { const int item = item0 + u * gridDim.x * 512, t = item >> 7, c = (item & 127) * 4;
            const f32x4 y = yv[u];
            const float mean = rowsum16(y[0] + y[1] + y[2] + y[3]) * (1.0f / 64.0f);
            const f32x4 d = y - mean;
            const float var = rowsum16(d[0] * d[0] + d[1] * d[1] + d[2] * d[2] + d[3] * d[3]) * (1.0f / 64.0f);
            const float rstd = rsqrtf(var + 64.0f * 1e-5f);
            st_bf4(MIX + (size_t)t * DM + c, (d * rstd * lw[u] + lb[u] + sb[u] * vv[u]) * gv[u]); }
    }
}

__device__ void phase_dbg_dump(const Params& p) {
    const unsigned* w = (const unsigned*)p.ws; unsigned* o = (unsigned*)p.out;
    const size_t NO = (size_t)T_ALL * DM + 2u * 32 * 8 * 64 * 64;
    for (size_t i = (size_t)blockIdx.x * 512 + threadIdx.x; i < NO; i += (size_t)gridDim.x * 512) {
        const bool useo = (i < (size_t)T_ALL * DM) ? (DBG_STOP >= 3 && !(P3_SKIP & 1)) : (DBG_STOP >= 4);
        unsigned v = (useo ? o[i] : 0u) ^ w[i] ^ (w[i + NO] * 3u) ^ (w[i + 2 * NO] * 5u);
        v ^= v >> 16; ((float*)o)[i] = (float)(v & 0xFFFFu);
    }
}
#define XB_TMO      128
#define XB_XCNT(j)  (256  + 64 * (j))
#define XB_XSUB(j)  (1280 + 64 * (j))
#define XB_XGEN(j)  (2304 + 64 * (j))
#define XB_TOP      3328
#define XB_TOPGEN   3392
#define XCD_BAR_WORDS 3456
#define XB_SPIN_CAP (1u << 18)
__device__ __forceinline__ unsigned xb_ld(unsigned* p)              { return __hip_atomic_load(p, __ATOMIC_RELAXED, __HIP_MEMORY_SCOPE_AGENT); }
__device__ __forceinline__ unsigned xb_add(unsigned* p, unsigned v) { return __hip_atomic_fetch_add(p, v, __ATOMIC_RELAXED, __HIP_MEMORY_SCOPE_AGENT); }
__device__ __forceinline__ unsigned xb_xcc_id() { return (unsigned)__builtin_amdgcn_s_getreg((3 << 11) | 20) & 0xFu; }
#define XB_SPIN(cond, bar) do { unsigned _sp = 0; while (cond) { if (_sp > 64u) __builtin_amdgcn_s_sleep(1);        \
    if ((++_sp & 255u) == 0u) { if (xb_ld(&(bar)[XB_TMO])) break; if (_sp > XB_SPIN_CAP) { atomicAdd(&(bar)[XB_TMO], 1u); break; } } } } while (0)
struct XcdBarrier { unsigned* bar; unsigned x; volatile LAS unsigned* st; };
__device__ __forceinline__ XcdBarrier xcd_barrier_post(unsigned* bar, volatile LAS unsigned* st) {
    XcdBarrier b; b.bar = bar; b.x = xb_xcc_id(); b.st = st;
    if (threadIdx.x == 0) (void)xb_add(&bar[XB_XCNT(b.x)], 1u);
    return b;
}
__device__ __forceinline__ void xcd_barrier_complete(unsigned* bar, unsigned x, unsigned& nloc, unsigned& nx) {
    const unsigned G = gridDim.x * gridDim.y * gridDim.z;
    unsigned sum, cnt, mine, sp = 0u;
    for (;;) {
        sum = 0u; cnt = 0u; mine = 0u;
#pragma unroll
        for (unsigned j = 0; j < 16; ++j) { const unsigned c = xb_ld(&bar[XB_XCNT(j)]); sum += c; cnt += (c > 0u) ? 1u : 0u; mine = (j == x) ? c : mine; }
        if (sum == G) break;
        __builtin_amdgcn_s_sleep(1);
        if ((++sp & 255u) == 0u) { if (xb_ld(&bar[XB_TMO])) break; if (sp > XB_SPIN_CAP) { atomicAdd(&bar[XB_TMO], 1u); break; } }
    }
    nloc = mine > 0u ? mine : 1u; nx = cnt > 0u ? cnt : 1u;
}
__device__ __forceinline__ void xcd_barrier(const XcdBarrier& b) {
    asm volatile("s_waitcnt vmcnt(0)" ::: "memory");
    __syncthreads();
    if (threadIdx.x == 0) {
        unsigned* bar = b.bar;
        __builtin_amdgcn_s_waitcnt(0);
        unsigned nloc = b.st[0], nx = b.st[1];
        if (nloc == 0u) { xcd_barrier_complete(bar, b.x, nloc, nx); b.st[0] = nloc; b.st[1] = nx; }
        const unsigned old = xb_add(&bar[XB_XSUB(b.x)], 1u);
        const unsigned gen = old / nloc;
        if (old + 1u == (gen + 1u) * nloc) {
            __builtin_amdgcn_fence(__ATOMIC_RELEASE, "agent");
            asm volatile("s_waitcnt vmcnt(0)" ::: "memory");
            const unsigned og = xb_add(&bar[XB_TOP], 1u);
            const unsigned tg = og / nx;
            if (og + 1u == (tg + 1u) * nx) xb_add(&bar[XB_TOPGEN], 1u);
            else XB_SPIN(xb_ld(&bar[XB_TOPGEN]) == tg, bar);
            __builtin_amdgcn_fence(__ATOMIC_ACQUIRE, "agent");
            xb_add(&bar[XB_XGEN(b.x)], 1u);
            asm volatile("s_waitcnt vmcnt(0)" ::: "memory");
        } else {
            XB_SPIN(xb_ld(&bar[XB_XGEN(b.x)]) == gen, bar);
            __builtin_amdgcn_fence(__ATOMIC_ACQUIRE, "agent");
            asm volatile("s_waitcnt vmcnt(0)" ::: "memory");
        }
    }
    __syncthreads();
}

__global__ void __launch_bounds__(512, 2) fwd_megakernel(Params p) {
    extern __shared__ __attribute__((aligned(16))) unsigned char shm[];
    cg::grid_group grid = cg::this_grid();
    volatile LAS unsigned* xbst = (volatile LAS unsigned*)((LAS unsigned char*)shm + 131072);
    if (threadIdx.x == 0) { xbst[0] = 0u; xbst[1] = 0u; }
    __syncthreads();
    const XcdBarrier xb = xcd_barrier_post((unsigned*)(p.ws + WS_BAR), xbst);
#define RUN(k) (((PH_MASK >> (k)) & 1) && p.ph_lo <= (k) && (k) < p.ph_hi && (DBG_STOP < 0 || (k) <= DBG_STOP))
#ifndef SYNC_REPS
#define SYNC_REPS 1
#endif
#define SEAM(k) do { if (p.ph_lo <= (k) && (k) + 1 < p.ph_hi) { __syncthreads(); xcd_barrier(xb); } } while (0)
    if (p.ph_hi > 1000) grid.sync();
    if (RUN(0)) phase_setup(p, shm);
    SEAM(0);
    if (RUN(1)) phase_norm<0>(p);
    SEAM(1);
    if (RUN(2)) { pg8::Gemm g{(const bf16_t*)(p.ws + WS_H), (const bf16_t*)(p.ws + WS_WIN), T_ALL, ZPAD, 1024}; pg8::StaticOrder S; S.init(T_ALL, ZPAD, (int)gridDim.x, (int)blockIdx.x);
                  EpiZ E{(bf16_t*)(p.ws + WS_Z)}; pg8::gemm_phase((LAS unsigned char*)shm, g, S, E); }
    SEAM(2);
    if (RUN(3)) phase_prep<0>(p, shm);
    if ((DUP_MASK >> 3) & 1) { __syncthreads(); phase_prep<P3DUP_SKIP>(p, shm); }
    SEAM(3);
    if (RUN(4)) phase_scan(p, shm);
    if ((DUP_MASK >> 4) & 1) { __syncthreads(); phase_scan(p, shm); }
    SEAM(4);
    if (RUN(5)) phase_combine(p);
    SEAM(5);
    if (RUN(6)) { pg8::Gemm g{(const bf16_t*)(p.ws + WS_MIX), (const bf16_t*)(p.ws + WS_WOUT), T_ALL, 1024, 1024}; pg8::StaticOrder S; S.init(T_ALL, 1024, (int)gridDim.x, (int)blockIdx.x);
                  EpiX1 E{p, (bf16_t*)(p.ws + WS_H)}; pg8::gemm_phase((LAS unsigned char*)shm, g, S, E); }
    SEAM(6);
    if (RUN(7)) phase_norm<1>(p);
    SEAM(7);
    if (RUN(8)) { pg8::Gemm g{(const bf16_t*)(p.ws + WS_MIX), (const bf16_t*)(p.ws + WS_W1), T_ALL, DFF, 1024}; pg8::StaticOrder S; S.init(T_ALL, DFF, (int)gridDim.x, (int)blockIdx.x);
                  EpiHid E{(bf16_t*)(p.ws + WS_HID)}; pg8::gemm_phase((LAS unsigned char*)shm, g, S, E);
                  if ((DUP_MASK >> 8) & 1) { __syncthreads(); pg8::gemm_phase((LAS unsigned char*)shm, g, S, E); } }
    SEAM(8);
    if (RUN(9)) { pg8::Gemm g{(const bf16_t*)(p.ws + WS_HID), (const bf16_t*)(p.ws + WS_W2), T_ALL, 1024, DFF}; pg8::StaticOrder S; S.init(T_ALL, 1024, (int)gridDim.x, (int)blockIdx.x);
                  EpiX2 E{p, (const bf16_t*)(p.ws + WS_H), (bf16_t*)(p.ws + WS_MIX)}; pg8::gemm_phase((LAS unsigned char*)shm, g, S, E); }
    SEAM(9);
    if (RUN(10)) phase_norm<2>(p);
    if (DBG_STOP >= 0 && p.ph_lo <= 11 && 11 < p.ph_hi) phase_dbg_dump(p);
}

extern "C" void kernel_launch(void* const* d_in, const int* in_sizes, int n_in, void* d_out, int out_size, void* d_ws, size_t ws_size, hipStream_t stream) {
    static int grid_blocks = 0;
    if (grid_blocks == 0) {
        int dev = 0, cus = 0, per_cu = 0;
        hipGetDevice(&dev);
        hipDeviceGetAttribute(&cus, hipDeviceAttributeMultiprocessorCount, dev);
        if (hipFuncSetAttribute((const void*)fwd_megakernel, hipFuncAttributeMaxDynamicSharedMemorySize, LDS_BYTES) != hipSuccess) fprintf(stderr, "hipFuncSetAttribute failed\n");
        if (hipOccupancyMaxActiveBlocksPerMultiprocessor(&per_cu, (const void*)fwd_megakernel, 512, LDS_BYTES) != hipSuccess || per_cu < 1) { fprintf(stderr, "occupancy query failed (%d)\n", per_cu); per_cu = 1; }
        if (per_cu > 1) per_cu = 1;
        grid_blocks = cus * per_cu;
        if (ws_size < WS_NEED || n_in != 32) fprintf(stderr, "kernel_launch: ws_size %zu < %zu or n_in %d != 32\n", ws_size, (size_t)WS_NEED, n_in);
    }
    Params p{};
    for (int i = 0; i < 32; ++i) p.in[i] = (const float*)d_in[i];
    p.out = (float*)d_out; p.ws = (unsigned char*)d_ws;
#if MK_MULTI
    for (int ph = 0; ph < (DBG_STOP >= 0 ? 12 : 11); ++ph) { p.ph_lo = ph; p.ph_hi = ph + 1; hipLaunchKernelGGL(fwd_megakernel, dim3(grid_blocks), dim3(512), LDS_BYTES, stream, p); }
#else
    p.ph_lo = 0; p.ph_hi = 11;
    if (hipMemsetAsync((unsigned char*)d_ws + WS_BAR, 0, XCD_BAR_WORDS * sizeof(unsigned), stream) != hipSuccess) fprintf(stderr, "barrier memset failed\n");
    void* args[] = {&p};
    hipError_t e = hipLaunchCooperativeKernel((const void*)fwd_megakernel, dim3(grid_blocks), dim3(512), args, LDS_BYTES, stream);
    if (e != hipSuccess) fprintf(stderr, "cooperative launch failed: %s (grid %d)\n", hipGetErrorString(e), grid_blocks);
#endif
}
```
